# Optimizing an MI355X kernel written in HIP

```python
import jax
import jax.numpy as jnp
from jax import lax
import numpy as np

D_MODEL = 2048
BATCH = 2
SEQ = 8192
DEPTH = 4

N_MIXERS = 3
D_FF = 5632
HALF_STEP = 0.5
NORM_EPS = 1e-6
NEG_INF = -1e30
ROPE_THETA = 500000.0

A_HEADS = 16
A_HEAD_DIM = 128
A_ROT_DIM = A_HEAD_DIM // 4
A_PATTERNS = ((128, 1), (512, 4), (2048, 16))
A_GROUPS = len(A_PATTERNS)
A_BLOCK = 128

B_HEADS = 16
B_Q_RANK = 1536
B_KV_RANK = 512
B_NOPE_DIM = 128
B_ROPE_DIM = 64
B_V_DIM = 128
B_BLOCK = 128

C_WIDTH = D_MODEL
C_CONV = 3

kernel_name = 'hybrid_dilated_mla_shortconv_macaron'


def rmsnorm(x, gain):
    xf = x.astype(jnp.float32)
    y = xf * lax.rsqrt(jnp.mean(xf * xf, axis=-1, keepdims=True) + NORM_EPS)
    return (y * gain.astype(jnp.float32)).astype(x.dtype)


def swiglu(x, w13, w2):
    gate, up = jnp.split(x @ w13, 2, axis=-1)
    return (jax.nn.silu(gate) * up) @ w2


def rope(t, positions, rot_dim):
    half = rot_dim // 2
    inv_freq = ROPE_THETA ** (-jnp.arange(half, dtype=jnp.float32) / half)
    ang = positions.astype(jnp.float32)[:, :, None, None] * inv_freq
    cos, sin = jnp.cos(ang), jnp.sin(ang)
    tf = t.astype(jnp.float32)
    t1, t2, rest = tf[..., :half], tf[..., half:rot_dim], tf[..., rot_dim:]
    out = jnp.concatenate([t1 * cos - t2 * sin, t2 * cos + t1 * sin, rest], axis=-1)
    return out.astype(t.dtype)


def dilated_branch(q, k, v, span, dilation):
    bsz, seq, heads, dh = q.shape
    sub = seq // dilation
    nb = -(-sub // A_BLOCK)
    pad = nb * A_BLOCK - sub

    def to_blocks(a):
        a = a.reshape(bsz, sub, dilation, heads, dh).transpose(0, 2, 1, 3, 4)
        a = jnp.pad(a, ((0, 0), (0, 0), (0, pad), (0, 0), (0, 0)))
        return a.reshape(bsz, dilation, nb, A_BLOCK, heads, dh)

    def with_prev(a):
        prev = jnp.pad(a, ((0, 0), (0, 0), (1, 0), (0, 0), (0, 0), (0, 0)))[:, :, :-1]
        return jnp.concatenate([prev, a], axis=3)

    qb = to_blocks(q)
    kw = with_prev(to_blocks(k))
    vw = with_prev(to_blocks(v))
    s = jnp.einsum('bcnqhd,bcnkhd->bcnhqk', qb, kw).astype(jnp.float32) * (dh ** -0.5)
    qi = jnp.arange(A_BLOCK)[:, None] + A_BLOCK
    ki = jnp.arange(2 * A_BLOCK)[None, :]
    dist = qi - ki
    band = (dist >= 0) & (dist <= span)
    has_prev = (jnp.arange(nb) > 0)[:, None, None] | (ki >= A_BLOCK)[None]
    mask = band[None] & has_prev
    s = jnp.where(mask[:, None], s, NEG_INF)
    m = jnp.max(s, axis=-1, keepdims=True)
    p = jnp.exp(s - m)
    l = jnp.sum(p, axis=-1, keepdims=True)
    o = jnp.einsum('bcnhqk,bcnkhd->bcnqhd', p / l, vw.astype(jnp.float32))
    lse = (m + jnp.log(l))[..., 0]

    o = o.reshape(bsz, dilation, nb * A_BLOCK, heads, dh)[:, :, :sub]
    o = o.transpose(0, 2, 1, 3, 4).reshape(bsz, seq, heads, dh)
    lse = lse.transpose(0, 1, 2, 4, 3).reshape(bsz, dilation, nb * A_BLOCK, heads)[:, :, :sub]
    lse = lse.transpose(0, 2, 1, 3).reshape(bsz, seq, heads)
    return o, lse


def dilated_mixer(h, positions, w_qkv, w_o):
    bsz, seq, _ = h.shape
    qkv = (h @ w_qkv).reshape(bsz, seq, A_GROUPS, 3, A_HEADS, A_HEAD_DIM)
    outs, lses = [], []
    for g, (window, dilation) in enumerate(A_PATTERNS):
        q = rope(qkv[:, :, g, 0], positions, A_ROT_DIM)
        k = rope(qkv[:, :, g, 1], positions, A_ROT_DIM)
        o, lse = dilated_branch(q, k, qkv[:, :, g, 2], window // dilation, dilation)
        outs.append(o)
        lses.append(lse)
    wts = jax.nn.softmax(jnp.stack(lses), axis=0)[..., None]
    o = jnp.sum(wts * jnp.stack(outs), axis=0)
    return o.reshape(bsz, seq, A_HEADS * A_HEAD_DIM).astype(h.dtype) @ w_o


def mla_mixer(h, positions, w_in, q_norm, w_uq, kv_norm, w_ukv, w_o):
    bsz, seq, _ = h.shape
    c_q, c_kv, k_rope = jnp.split(h @ w_in, [B_Q_RANK, B_Q_RANK + B_KV_RANK], axis=-1)
    q = (rmsnorm(c_q, q_norm) @ w_uq).reshape(bsz, seq, B_HEADS, B_NOPE_DIM + B_ROPE_DIM)
    q_nope = q[..., :B_NOPE_DIM]
    q_rope = rope(q[..., B_NOPE_DIM:], positions, B_ROPE_DIM)
    k_rope = rope(k_rope[:, :, None, :], positions, B_ROPE_DIM)[:, :, 0]
    kv = (rmsnorm(c_kv, kv_norm) @ w_ukv).reshape(bsz, seq, B_HEADS, B_NOPE_DIM + B_V_DIM)
    k_nope, v = kv[..., :B_NOPE_DIM], kv[..., B_NOPE_DIM:]
    vf = v.astype(jnp.float32)
    scale = (B_NOPE_DIM + B_ROPE_DIM) ** -0.5
    nq = seq // B_BLOCK
    key_pos = jnp.arange(seq)

    def blocks(a):
        return a.reshape((bsz, nq, B_BLOCK) + a.shape[2:]).swapaxes(0, 1)

    def attend(args):
        start, qn, qr = args
        s = (jnp.einsum('bqhd,bkhd->bhqk', qn, k_nope)
             + jnp.einsum('bqhd,bkd->bhqk', qr, k_rope)).astype(jnp.float32) * scale
        causal = (start + jnp.arange(B_BLOCK))[:, None] >= key_pos[None, :]
        p = jax.nn.softmax(jnp.where(causal, s, NEG_INF), axis=-1)
        return jnp.einsum('bhqk,bkhd->bqhd', p, vf)

    o = lax.map(attend, (jnp.arange(nq) * B_BLOCK, blocks(q_nope), blocks(q_rope)))
    o = o.swapaxes(0, 1).reshape(bsz, seq, B_HEADS * B_V_DIM)
    return o.astype(h.dtype) @ w_o


def short_conv_mixer(h, w_in, conv_w, w_out):
    b_gate, c_gate, u = jnp.split(h @ w_in, 3, axis=-1)
    z = lax.conv_general_dilated(c_gate * u, conv_w[:, None, :], window_strides=(1,),
                                 padding=[(C_CONV - 1, 0)],
                                 dimension_numbers=('NWC', 'WIO', 'NWC'),
                                 feature_group_count=C_WIDTH)
    return (b_gate * z) @ w_out


def setup_inputs(seed: int = 0) -> dict:
    key = jax.random.key(seed)
    keys = jax.random.split(key, 128)
    counter = [0]

    def nk():
        counter[0] += 1
        return keys[counter[0] - 1]

    def dense(fan_in, fan_out):
        return jax.random.normal(nk(), (fan_in, fan_out), jnp.float32) * fan_in ** -0.5

    def gain(n):
        return 1.0 + 0.02 * jax.random.normal(nk(), (n,), jnp.float32)

    inp = {}
    inp['x'] = jax.random.normal(nk(), (BATCH, SEQ, D_MODEL), jnp.float32)
    offset = jax.random.randint(nk(), (BATCH, 1), 0, 4096, dtype=jnp.int32)
    inp['positions'] = offset + jnp.arange(SEQ, dtype=jnp.int32)[None, :]
    for i in range(DEPTH):
        p = 'l%d_' % i
        inp[p + 'ffn1_norm'] = gain(D_MODEL)
        inp[p + 'ffn1_w13'] = dense(D_MODEL, 2 * D_FF)
        inp[p + 'ffn1_w2'] = dense(D_FF, D_MODEL)
        inp[p + 'mix_norm'] = gain(D_MODEL)
        kind = i % N_MIXERS
        if kind == 0:
            inp[p + 'a_w_qkv'] = dense(D_MODEL, A_GROUPS * 3 * A_HEADS * A_HEAD_DIM)
            inp[p + 'a_w_o'] = dense(A_HEADS * A_HEAD_DIM, D_MODEL)
        elif kind == 1:
            inp[p + 'b_w_in'] = dense(D_MODEL, B_Q_RANK + B_KV_RANK + B_ROPE_DIM)
            inp[p + 'b_q_norm'] = gain(B_Q_RANK)
            inp[p + 'b_w_uq'] = dense(B_Q_RANK, B_HEADS * (B_NOPE_DIM + B_ROPE_DIM))
            inp[p + 'b_kv_norm'] = gain(B_KV_RANK)
            inp[p + 'b_w_ukv'] = dense(B_KV_RANK, B_HEADS * (B_NOPE_DIM + B_V_DIM))
            inp[p + 'b_w_o'] = dense(B_HEADS * B_V_DIM, D_MODEL)
        else:
            inp[p + 'c_w_in'] = dense(D_MODEL, 3 * C_WIDTH)
            inp[p + 'c_conv_w'] = jax.random.normal(nk(), (C_CONV, C_WIDTH), jnp.float32) * C_CONV ** -0.5
            inp[p + 'c_w_out'] = dense(C_WIDTH, D_MODEL)
        inp[p + 'ffn2_norm'] = gain(D_MODEL)
        inp[p + 'ffn2_w13'] = dense(D_MODEL, 2 * D_FF)
        inp[p + 'ffn2_w2'] = dense(D_FF, D_MODEL)
    inp['final_norm'] = gain(D_MODEL)
    return inp


def reference(x, positions,
              l0_ffn1_norm, l0_ffn1_w13, l0_ffn1_w2, l0_mix_norm, l0_a_w_qkv, l0_a_w_o,
              l0_ffn2_norm, l0_ffn2_w13, l0_ffn2_w2,
              l1_ffn1_norm, l1_ffn1_w13, l1_ffn1_w2, l1_mix_norm, l1_b_w_in, l1_b_q_norm,
              l1_b_w_uq, l1_b_kv_norm, l1_b_w_ukv, l1_b_w_o,
              l1_ffn2_norm, l1_ffn2_w13, l1_ffn2_w2,
              l2_ffn1_norm, l2_ffn1_w13, l2_ffn1_w2, l2_mix_norm, l2_c_w_in, l2_c_conv_w, l2_c_w_out,
              l2_ffn2_norm, l2_ffn2_w13, l2_ffn2_w2,
              l3_ffn1_norm, l3_ffn1_w13, l3_ffn1_w2, l3_mix_norm, l3_a_w_qkv, l3_a_w_o,
              l3_ffn2_norm, l3_ffn2_w13, l3_ffn2_w2,
              final_norm):
    ffn = [
        (l0_ffn1_norm, l0_ffn1_w13, l0_ffn1_w2, l0_mix_norm, l0_ffn2_norm, l0_ffn2_w13, l0_ffn2_w2),
        (l1_ffn1_norm, l1_ffn1_w13, l1_ffn1_w2, l1_mix_norm, l1_ffn2_norm, l1_ffn2_w13, l1_ffn2_w2),
        (l2_ffn1_norm, l2_ffn1_w13, l2_ffn1_w2, l2_mix_norm, l2_ffn2_norm, l2_ffn2_w13, l2_ffn2_w2),
        (l3_ffn1_norm, l3_ffn1_w13, l3_ffn1_w2, l3_mix_norm, l3_ffn2_norm, l3_ffn2_w13, l3_ffn2_w2),
    ]
    mixers = [
        lambda t: dilated_mixer(t, positions, l0_a_w_qkv, l0_a_w_o),
        lambda t: mla_mixer(t, positions, l1_b_w_in, l1_b_q_norm, l1_b_w_uq,
                            l1_b_kv_norm, l1_b_w_ukv, l1_b_w_o),
        lambda t: short_conv_mixer(t, l2_c_w_in, l2_c_conv_w, l2_c_w_out),
        lambda t: dilated_mixer(t, positions, l3_a_w_qkv, l3_a_w_o),
    ]
    h = x
    for i in range(DEPTH):
        n1, w13a, w2a, nm, n2, w13b, w2b = ffn[i]
        h = h + HALF_STEP * swiglu(rmsnorm(h, n1), w13a, w2a)
        h = h + mixers[i](rmsnorm(h, nm))
        h = h + HALF_STEP * swiglu(rmsnorm(h, n2), w13b, w2b)
    return rmsnorm(h, final_norm)
```

```cpp
#include <hip/hip_runtime.h>
#include <cstdio>
#include <cstdint>
#include <cmath>
#define MK_PER_PHASE 1
namespace pg8 {
#define PG8_LAS __attribute__((address_space(3)))
typedef unsigned short bf16_t;
typedef short bf16x8 __attribute__((ext_vector_type(8)));
typedef float f32x4 __attribute__((ext_vector_type(4)));
typedef unsigned u32x4 __attribute__((ext_vector_type(4)));
constexpr int BM = 256, BK = 64, HALF = 128, HTB = HALF * BK * 2  , STAGE_BYTES = 8 * HTB, NXCD = 8, WGM = 8;

__host__ __device__ __forceinline__ int lds_byte(int r, int c) { const int st = (r >> 4) * 2 + (c >> 5), rr = r & 15, cc = c & 31, ob = rr * 64 + cc * 2; return st * 1024 + (ob ^ (((ob >> 9) & 1) << 5)); }
__host__ __device__ __forceinline__ void stage_rc(int b, int& R, int& C) { const int st = b / 1024, sb = b % 1024, swz = sb ^ (((sb >> 9) & 1) << 5); R = (st >> 1) * 16 + swz / 64; C = (st & 1) * 32 + (swz % 64) / 2; }
__host__ __device__ __forceinline__ int perm32(int rho) { const int n = rho >> 4, i = rho & 15; return 8 * (i >> 2) + 4 * n + (i & 3); }

struct Unit { int pm, pn; };
struct Gemm { const bf16_t* A; const bf16_t* Bt; int M, N, K; };

struct StaticOrder {
    int nM, nN, nwg, G, c;
    __host__ __device__ void init(int M, int N, int G_, int c_) { nM = M / BM; nN = N / BM; nwg = nM * nN; G = G_; c = c_; }
    __host__ __device__ bool next(int i, Unit& u) const {
        const long L = (long)i * G + c; if (L >= nwg) return false;
        int wgid = (int)L; { const int q = nwg / NXCD, r = nwg % NXCD, xcd = wgid % NXCD, off = wgid / NXCD; wgid = (xcd < r ? xcd * (q + 1) : r * (q + 1) + (xcd - r) * q) + off; }
        const int nig = WGM * nN, gid = wgid / nig, fm = gid * WGM, gsz = (nM - fm) < WGM ? (nM - fm) : WGM;
        u.pm = fm + ((wgid % nig) % gsz); u.pn = (wgid % nig) / gsz; return true;
    }
    __device__ __forceinline__ void a_ready(const Unit&) const {}
    __device__ __forceinline__ void done(const Unit&) const {}
};
__device__ __forceinline__ unsigned cvt_pk_bf16(float lo, float hi) { unsigned r; asm volatile("v_cvt_pk_bf16_f32 %0, %1, %2" : "=v"(r) : "v"(lo), "v"(hi)); return r; }
typedef float f32x2e __attribute__((ext_vector_type(2)));
constexpr float NORM_EPS = 1e-6f;
template <int NPF> __device__ __forceinline__ float row_rstd(const float* SS, int row, int stride, int fq, float inv_n) {
    const float* p = SS + (size_t)row * stride + fq * NPF; float s;
    if constexpr (NPF == 8) { const f32x4 a = *(const f32x4*)p, b = *(const f32x4*)(p + 4); s = ((a[0] + a[1]) + (a[2] + a[3])) + ((b[0] + b[1]) + (b[2] + b[3])); }
    else if constexpr (NPF == 6) { const f32x2e a = *(const f32x2e*)p, b = *(const f32x2e*)(p + 2), c = *(const f32x2e*)(p + 4); s = (a[0] + a[1]) + (b[0] + b[1]) + (c[0] + c[1]); }
    else { const f32x2e a = *(const f32x2e*)p; s = a[0] + a[1]; }
    s += __shfl_xor(s, 16); s += __shfl_xor(s, 32);
    return 1.0f / sqrtf(s * inv_n + NORM_EPS);
}
__device__ __forceinline__ u32x4 pack8bf(const f32x4 v0, const f32x4 v1) { u32x4 w; w.x = cvt_pk_bf16(v0[0], v0[1]); w.y = cvt_pk_bf16(v0[2], v0[3]); w.z = cvt_pk_bf16(v1[0], v1[1]); w.w = cvt_pk_bf16(v1[2], v1[3]); return w; }
__device__ __forceinline__ float dot4(const f32x4 a) { return (a[0] * a[0] + a[1] * a[1]) + (a[2] * a[2] + a[3] * a[3]); }
__device__ __forceinline__ f32x4 silu_mul(const f32x4 g, const f32x4 u) { f32x4 o;
#pragma unroll
    for (int j = 0; j < 4; ++j) { const float e = __builtin_amdgcn_exp2f(g[j] * -1.4426950408889634f); o[j] = g[j] * __builtin_amdgcn_rcpf(1.0f + e) * u[j]; }
    return o; }

struct EpiSwiGLU {
    static constexpr bool PERM = true, AFTER_DRAIN = false;
    bf16_t* O; int ldc; const float* SS;
    __device__ __forceinline__ void operator()(const f32x4 (&acc)[2][2][4][2], const Unit& u, int wr, int wc, int fr, int fq) const {
        const int row0 = u.pm * BM + wr * 64 + fr, col0 = u.pn * HALF + wc * 32 + 8 * fq;
#pragma unroll
        for (int ai = 0; ai < 2; ++ai)
#pragma unroll
            for (int m = 0; m < 4; ++m) { const int row = row0 + ai * HALF + m * 16; const float rs = row_rstd<8>(SS, row, 32, fq, 1.0f / 2048.0f);
                const f32x4 y0 = silu_mul(acc[ai][0][m][0] * rs, acc[ai][1][m][0] * rs), y1 = silu_mul(acc[ai][0][m][1] * rs, acc[ai][1][m][1] * rs);
                *(u32x4*)(O + (size_t)row * ldc + col0) = pack8bf(y0, y1); asm volatile("" ::: "memory"); }
    }
};
struct EpiResid {
    static constexpr bool PERM = true, AFTER_DRAIN = false;
    const float* base; float* out; bf16_t* hb; float* SSo; float alpha;
    __device__ __forceinline__ void operator()(const f32x4 (&acc)[2][2][4][2], const Unit& u, int wr, int wc, int fr, int fq) const {
        const int row0 = u.pm * BM + wr * 64 + fr, col0 = u.pn * BM + wc * 32 + 8 * fq;
#pragma unroll
        for (int ai = 0; ai < 2; ++ai)
#pragma unroll
            for (int m = 0; m < 4; ++m) { const int row = row0 + ai * HALF + m * 16; float s = 0.f;
#pragma unroll
                for (int bj = 0; bj < 2; ++bj) { const size_t off = (size_t)row * 2048 + col0 + bj * HALF;
                    const f32x4 b0 = *(const f32x4*)(base + off), b1 = *(const f32x4*)(base + off + 4);
                    const f32x4 h0 = b0 + acc[ai][bj][m][0] * alpha, h1 = b1 + acc[ai][bj][m][1] * alpha;
                    *(f32x4*)(out + off) = h0; *(f32x4*)(out + off + 4) = h1; *(u32x4*)(hb + off) = pack8bf(h0, h1);
                    s += dot4(h0) + dot4(h1); }
                s += __shfl_xor(s, 16); s += __shfl_xor(s, 32);
                if (fq == 0) SSo[(size_t)row * 32 + u.pn * 4 + wc] = s;
                asm volatile("" ::: "memory"); }
    }
};
struct EpiQKVA {
    static constexpr bool PERM = true, AFTER_DRAIN = false;
    bf16_t* O; const float* SS; const float* cosT; const float* sinT;
    __device__ __forceinline__ void operator()(const f32x4 (&acc)[2][2][4][2], const Unit& u, int wr, int wc, int fr, int fq) const {
        const int row0 = u.pm * BM + wr * 64 + fr, col0 = u.pn * BM + wc * 32 + 8 * fq;
        const int t = (u.pn >> 3) % 3; const bool rope = (t != 2) && (wc == 0);
#pragma unroll
        for (int ai = 0; ai < 2; ++ai)
#pragma unroll
            for (int m = 0; m < 4; ++m) { const int row = row0 + ai * HALF + m * 16; const float rs = row_rstd<8>(SS, row, 32, fq, 1.0f / 2048.0f);
                f32x4 c = {1.f, 1.f, 1.f, 1.f}, s = {0.f, 0.f, 0.f, 0.f};
                if (rope) { c = *(const f32x4*)(cosT + (size_t)row * 16 + 4 * fq); s = *(const f32x4*)(sinT + (size_t)row * 16 + 4 * fq); }
#pragma unroll
                for (int bj = 0; bj < 2; ++bj) { f32x4 v0 = acc[ai][bj][m][0] * rs, v1 = acc[ai][bj][m][1] * rs;
                    if (rope) { const f32x4 o0 = v0 * c - v1 * s, o1 = v1 * c + v0 * s; v0 = o0; v1 = o1; }
                    *(u32x4*)(O + (size_t)row * 18432 + col0 + bj * HALF) = pack8bf(v0, v1); } asm volatile("" ::: "memory"); }
    }
};
struct EpiBin {
    static constexpr bool PERM = true, AFTER_DRAIN = false;
    bf16_t* CQ; bf16_t* CKV; bf16_t* KR; float* SSQ; float* SSKV; const float* SS; const float* cosT; const float* sinT;
    __device__ __forceinline__ void operator()(const f32x4 (&acc)[2][2][4][2], const Unit& u, int wr, int wc, int fr, int fq) const {
        const int row0 = u.pm * BM + wr * 64 + fr; const int pn = u.pn;
#pragma unroll
        for (int ai = 0; ai < 2; ++ai)
#pragma unroll
            for (int m = 0; m < 4; ++m) { const int row = row0 + ai * HALF + m * 16; const float rs = row_rstd<8>(SS, row, 32, fq, 1.0f / 2048.0f);
                if (pn < 8) {
                    bf16_t* dst; float* ssd;
                    if (pn < 6) { dst = CQ + (size_t)row * 1536 + pn * BM; ssd = SSQ + (size_t)row * 32 + pn * 4 + wc; }
                    else { dst = CKV + (size_t)row * 512 + (pn - 6) * BM; ssd = SSKV + (size_t)row * 8 + (pn - 6) * 4 + wc; }
                    float s = 0.f;
#pragma unroll
                    for (int bj = 0; bj < 2; ++bj) { const f32x4 v0 = acc[ai][bj][m][0] * rs, v1 = acc[ai][bj][m][1] * rs; s += dot4(v0) + dot4(v1);
                        *(u32x4*)(dst + bj * HALF + wc * 32 + 8 * fq) = pack8bf(v0, v1); }
                    s += __shfl_xor(s, 16); s += __shfl_xor(s, 32);
                    if (fq == 0) *ssd = s;
                } else if (wc == 0) {
                    const f32x4 x1a = acc[ai][0][m][0] * rs, x1b = acc[ai][0][m][1] * rs, x2a = acc[ai][1][m][0] * rs, x2b = acc[ai][1][m][1] * rs;
                    const float* cp = cosT + (size_t)row * 32 + 8 * fq; const float* sp = sinT + (size_t)row * 32 + 8 * fq;
                    const f32x4 c0 = *(const f32x4*)cp, c1 = *(const f32x4*)(cp + 4), s0 = *(const f32x4*)sp, s1 = *(const f32x4*)(sp + 4);
                    *(u32x4*)(KR + (size_t)row * 64 + 8 * fq) = pack8bf(x1a * c0 - x2a * s0, x1b * c1 - x2b * s1);
                    *(u32x4*)(KR + (size_t)row * 64 + 32 + 8 * fq) = pack8bf(x2a * c0 + x1a * s0, x2b * c1 + x1b * s1);
                } asm volatile("" ::: "memory"); }
    }
};
struct EpiUQ {
    static constexpr bool PERM = true, AFTER_DRAIN = false;
    bf16_t* QN; bf16_t* QRo; const float* SSQ; const float* cosT; const float* sinT;
    __device__ __forceinline__ void operator()(const f32x4 (&acc)[2][2][4][2], const Unit& u, int wr, int wc, int fr, int fq) const {
        const int row0 = u.pm * BM + wr * 64 + fr; const int pn = u.pn;
#pragma unroll
        for (int ai = 0; ai < 2; ++ai)
#pragma unroll
            for (int m = 0; m < 4; ++m) { const int row = row0 + ai * HALF + m * 16; const float rs = row_rstd<6>(SSQ, row, 32, fq, 1.0f / 1536.0f);
                if (pn < 8) {
#pragma unroll
                    for (int bj = 0; bj < 2; ++bj) *(u32x4*)(QN + (size_t)row * 2048 + pn * BM + bj * HALF + wc * 32 + 8 * fq) = pack8bf(acc[ai][bj][m][0] * rs, acc[ai][bj][m][1] * rs);
                } else {
                    const int head = (pn - 8) * 4 + wc;
                    const f32x4 x1a = acc[ai][0][m][0] * rs, x1b = acc[ai][0][m][1] * rs, x2a = acc[ai][1][m][0] * rs, x2b = acc[ai][1][m][1] * rs;
                    const float* cp = cosT + (size_t)row * 32 + 8 * fq; const float* sp = sinT + (size_t)row * 32 + 8 * fq;
                    const f32x4 c0 = *(const f32x4*)cp, c1 = *(const f32x4*)(cp + 4), s0 = *(const f32x4*)sp, s1 = *(const f32x4*)(sp + 4);
                    bf16_t* d = QRo + (size_t)row * 1024 + head * 64 + 8 * fq;
                    *(u32x4*)d = pack8bf(x1a * c0 - x2a * s0, x1b * c1 - x2b * s1);
                    *(u32x4*)(d + 32) = pack8bf(x2a * c0 + x1a * s0, x2b * c1 + x1b * s1);
                } asm volatile("" ::: "memory"); }
    }
};
struct EpiUKV {
    static constexpr bool PERM = true, AFTER_DRAIN = false;
    bf16_t* KN; bf16_t* VB; const float* SSKV;
    __device__ __forceinline__ void operator()(const f32x4 (&acc)[2][2][4][2], const Unit& u, int wr, int wc, int fr, int fq) const {
        const int row0 = u.pm * BM + wr * 64 + fr; const int col0 = u.pn * HALF + wc * 32 + 8 * fq;
#pragma unroll
        for (int ai = 0; ai < 2; ++ai)
#pragma unroll
            for (int m = 0; m < 4; ++m) { const int row = row0 + ai * HALF + m * 16; const float rs = row_rstd<2>(SSKV, row, 8, fq, 1.0f / 512.0f);
                *(u32x4*)(KN + (size_t)row * 2048 + col0) = pack8bf(acc[ai][0][m][0] * rs, acc[ai][0][m][1] * rs);
                *(u32x4*)(VB + (size_t)row * 2048 + col0) = pack8bf(acc[ai][1][m][0] * rs, acc[ai][1][m][1] * rs); asm volatile("" ::: "memory"); }
    }
};
struct EpiCin {
    static constexpr bool PERM = true, AFTER_DRAIN = false;
    bf16_t* CU; bf16_t* BG; const float* SS;
    __device__ __forceinline__ void operator()(const f32x4 (&acc)[2][2][4][2], const Unit& u, int wr, int wc, int fr, int fq) const {
        const int row0 = u.pm * BM + wr * 64 + fr; const int pn = u.pn;
#pragma unroll
        for (int ai = 0; ai < 2; ++ai)
#pragma unroll
            for (int m = 0; m < 4; ++m) { const int row = row0 + ai * HALF + m * 16; const float rs = row_rstd<8>(SS, row, 32, fq, 1.0f / 2048.0f);
                if (pn < 16) { const float r2 = rs * rs;
                    *(u32x4*)(CU + (size_t)row * 2048 + pn * HALF + wc * 32 + 8 * fq) = pack8bf(acc[ai][0][m][0] * acc[ai][1][m][0] * r2, acc[ai][0][m][1] * acc[ai][1][m][1] * r2);
                } else {
#pragma unroll
                    for (int bj = 0; bj < 2; ++bj) *(u32x4*)(BG + (size_t)row * 2048 + (pn - 16) * BM + bj * HALF + wc * 32 + 8 * fq) = pack8bf(acc[ai][bj][m][0] * rs, acc[ai][bj][m][1] * rs);
                } asm volatile("" ::: "memory"); }
    }
};
template <class Epi, class Sched, bool ALIGN_EPI = false, bool SP2 = false>
__device__ __forceinline__ void gemm_phase(PG8_LAS unsigned char* lds, const Gemm g, const Sched& S, const Epi& E) {
    int tid_ = threadIdx.x; asm volatile("" : "+v"(tid_));
    const int tid = tid_, wid = __builtin_amdgcn_readfirstlane(tid >> 6), lane = tid & 63, wr = wid >> 2, wc = wid & 3, fr = lane & 15, fq = lane >> 4;
    const int K = g.K, nt = K / BK;
    unsigned voffA[2], voffB[2];
#pragma unroll
    for (int i = 0; i < 2; ++i) { int R, C; stage_rc(tid * 16 + i * 8192, R, C); const int Rb = Epi::PERM ? ((R & ~31) + perm32(R & 31)) : R;
        voffA[i] = (unsigned)(R * K + C) * 2u; voffB[i] = (unsigned)(Rb * K + C) * 2u; }
    const size_t kstep = (size_t)(BK * 2);
    const size_t hstep = (size_t)HALF * K * 2;
    const size_t tstep = 2 * hstep;
    const unsigned ldsw = (unsigned)wid * 1024u;
    const int aoff = lds_byte(wr * 64 + fr, fq * 8), boff = lds_byte(wc * 32 + fr, fq * 8);
#define PG8_SA(b, h) (((b) * 2 + (h)) * HTB)
#define PG8_SB(b, h) ((4 + (b) * 2 + (h)) * HTB)
#define PG8_STAGE(bufoff, gbase, voff) do { _Pragma("unroll") for (int _i = 0; _i < 2; ++_i) \
        __builtin_amdgcn_global_load_lds((const unsigned*)((const char*)(gbase) + (voff)[_i]), (PG8_LAS unsigned*)(lds + (bufoff) + ldsw + _i * 8192), 16, 0, 0); } while (0)
#define PG8_LDA(dst, b, h) do { _Pragma("unroll") for (int m = 0; m < 4; ++m) _Pragma("unroll") for (int k = 0; k < 2; ++k) dst[m][k] = *(const PG8_LAS bf16x8*)(lds + PG8_SA(b, h) + aoff + m * 2048 + k * 1024); } while (0)
#define PG8_LDB(dst, b, h) do { _Pragma("unroll") for (int n = 0; n < 2; ++n) _Pragma("unroll") for (int k = 0; k < 2; ++k) dst[n][k] = *(const PG8_LAS bf16x8*)(lds + PG8_SB(b, h) + boff + n * 2048 + k * 1024); } while (0)
#define PG8_MMA(ai, bj, At, Bt) do { __builtin_amdgcn_s_setprio(1); _Pragma("unroll") for (int m = 0; m < 4; ++m) _Pragma("unroll") for (int n = 0; n < 2; ++n) _Pragma("unroll") for (int k = 0; k < 2; ++k) \
        acc[ai][bj][m][n] = __builtin_amdgcn_mfma_f32_16x16x32_bf16(Bt[n][k], At[m][k], acc[ai][bj][m][n], 0, 0, 0); __builtin_amdgcn_s_setprio(0); } while (0)
#define PG8_WAIT_V(n) asm volatile("s_waitcnt vmcnt(" #n ")" ::: "memory")
#define PG8_WAIT_L(n) asm volatile("s_waitcnt lgkmcnt(" #n ")" ::: "memory")
#define PG8_BAR __builtin_amdgcn_s_barrier()
#define PG8_SCHED __builtin_amdgcn_sched_barrier(0)
    Unit cur, nxt; int ui = 0;
    if (!S.next(0, cur)) return;
    f32x4 acc[2][2][4][2];
#pragma unroll
    for (int a = 0; a < 2; ++a)
#pragma unroll
        for (int b = 0; b < 2; ++b)
#pragma unroll
            for (int m = 0; m < 4; ++m)
#pragma unroll
                for (int n = 0; n < 2; ++n) acc[a][b][m][n] = (f32x4){0.f, 0.f, 0.f, 0.f};
    bf16x8 At[4][2], B0[2][2], B1[2][2];
    const char* cA = (const char*)g.A + (size_t)cur.pm * tstep; const char* cB = (const char*)g.Bt + (size_t)cur.pn * tstep;
    S.a_ready(cur);
    if constexpr (SP2) {
        PG8_STAGE(PG8_SB(0, 0), cB, voffB); PG8_STAGE(PG8_SB(0, 1), cB + hstep, voffB); PG8_STAGE(PG8_SA(0, 0), cA, voffA); PG8_STAGE(PG8_SA(0, 1), cA + hstep, voffA);
        if (wr == 1) PG8_BAR;
        PG8_WAIT_V(2); PG8_BAR;
        PG8_STAGE(PG8_SB(1, 0), cB + kstep, voffB); PG8_STAGE(PG8_SA(1, 0), cA + kstep, voffA); PG8_STAGE(PG8_SB(1, 1), cB + hstep + kstep, voffB);
        PG8_WAIT_V(6); PG8_BAR;
    } else {
        PG8_STAGE(PG8_SB(0, 0), cB, voffB); PG8_STAGE(PG8_SA(0, 0), cA, voffA); PG8_STAGE(PG8_SB(0, 1), cB + hstep, voffB); PG8_STAGE(PG8_SA(0, 1), cA + hstep, voffA);
        if (wr == 1) PG8_BAR;
        PG8_WAIT_V(4); PG8_BAR;
        PG8_STAGE(PG8_SB(1, 0), cB + kstep, voffB); PG8_STAGE(PG8_SA(1, 0), cA + kstep, voffA); PG8_STAGE(PG8_SB(1, 1), cB + hstep + kstep, voffB);
        PG8_WAIT_V(6); PG8_BAR;
    }
    for (;;) {
        const bool has_next = S.next(ui + 1, nxt);
        const char* nA = has_next ? (const char*)g.A + (size_t)nxt.pm * tstep : cA; const char* nB = has_next ? (const char*)g.Bt + (size_t)nxt.pn * tstep : cB;
        for (int t = 0; t < nt; t += 2) {
            const bool last = (t == nt - 2);
            const char* a1 = cA + (size_t)(t + 1) * kstep;
            const char* a2 = last ? nA : cA + (size_t)(t + 2) * kstep; const char* b2 = last ? nB : cB + (size_t)(t + 2) * kstep;
            const char* a3 = a2 + kstep; const char* b3 = b2 + kstep;
            if (last && has_next) S.a_ready(nxt);
            if constexpr (SP2) {
            PG8_LDB(B0, 0, 0); PG8_LDB(B1, 0, 1); PG8_SCHED; PG8_LDA(At, 0, 0); PG8_STAGE(PG8_SA(1, 1), a1 + hstep, voffA);
            PG8_WAIT_V(8); PG8_WAIT_L(0); PG8_BAR; PG8_MMA(0, 0, At, B0); PG8_MMA(0, 1, At, B1); PG8_BAR; PG8_SCHED;
            PG8_LDA(At, 0, 1); PG8_STAGE(PG8_SB(0, 0), b2, voffB); PG8_STAGE(PG8_SB(0, 1), b2 + hstep, voffB); PG8_STAGE(PG8_SA(0, 0), a2, voffA);
            PG8_WAIT_V(8); PG8_WAIT_L(0); PG8_BAR; PG8_MMA(1, 0, At, B0); PG8_MMA(1, 1, At, B1); PG8_BAR; PG8_SCHED;
            PG8_LDB(B0, 1, 0); PG8_LDB(B1, 1, 1); PG8_SCHED; PG8_LDA(At, 1, 0); PG8_STAGE(PG8_SA(0, 1), a2 + hstep, voffA);
            PG8_WAIT_V(8); PG8_WAIT_L(0); PG8_BAR; PG8_MMA(0, 0, At, B0); PG8_MMA(0, 1, At, B1); PG8_BAR; PG8_SCHED;
            PG8_LDA(At, 1, 1); PG8_STAGE(PG8_SB(1, 0), b3, voffB); PG8_STAGE(PG8_SB(1, 1), b3 + hstep, voffB); PG8_STAGE(PG8_SA(1, 0), a3, voffA);
            PG8_WAIT_V(8); PG8_WAIT_L(0); PG8_BAR; PG8_MMA(1, 0, At, B0); PG8_MMA(1, 1, At, B1); PG8_BAR; PG8_SCHED;
            } else {
            PG8_LDB(B0, 0, 0); PG8_SCHED; PG8_LDA(At, 0, 0); PG8_STAGE(PG8_SA(1, 1), a1 + hstep, voffA);
            PG8_WAIT_L(8); PG8_BAR; PG8_WAIT_L(0); PG8_MMA(0, 0, At, B0); PG8_BAR; PG8_SCHED;
            PG8_LDB(B1, 0, 1); PG8_STAGE(PG8_SB(0, 0), b2, voffB);
            PG8_BAR; PG8_WAIT_L(0); PG8_MMA(0, 1, At, B1); PG8_BAR;
            PG8_LDA(At, 0, 1); PG8_STAGE(PG8_SA(0, 0), a2, voffA);
            PG8_BAR; PG8_WAIT_L(0); PG8_MMA(1, 0, At, B0); PG8_BAR; PG8_SCHED;
            PG8_STAGE(PG8_SB(0, 1), b2 + hstep, voffB);
            PG8_WAIT_V(6); PG8_BAR; PG8_MMA(1, 1, At, B1); PG8_BAR;
            PG8_LDB(B0, 1, 0); PG8_SCHED; PG8_LDA(At, 1, 0); PG8_STAGE(PG8_SA(0, 1), a2 + hstep, voffA);
            PG8_WAIT_L(8); PG8_BAR; PG8_WAIT_L(0); PG8_MMA(0, 0, At, B0); PG8_BAR; PG8_SCHED;
            PG8_LDB(B1, 1, 1); PG8_STAGE(PG8_SB(1, 0), b3, voffB);
            PG8_BAR; PG8_WAIT_L(0); PG8_MMA(0, 1, At, B1); PG8_BAR;
            PG8_LDA(At, 1, 1); PG8_STAGE(PG8_SA(1, 0), a3, voffA);
            PG8_BAR; PG8_WAIT_L(0); PG8_MMA(1, 0, At, B0); PG8_BAR; PG8_SCHED;
            PG8_STAGE(PG8_SB(1, 1), b3 + hstep, voffB);
            PG8_WAIT_V(6); PG8_BAR; PG8_MMA(1, 1, At, B1); PG8_BAR;
            }
        }
        if constexpr (ALIGN_EPI) { if (wr == 0) PG8_BAR; }
        if constexpr (!Epi::AFTER_DRAIN) { E(acc, cur, wr, wc, fr, fq); S.done(cur); }
        if (!has_next) break;
#pragma unroll
        for (int a = 0; a < 2; ++a)
#pragma unroll
            for (int b = 0; b < 2; ++b)
#pragma unroll
                for (int m = 0; m < 4; ++m)
#pragma unroll
                    for (int n = 0; n < 2; ++n) acc[a][b][m][n] = (f32x4){0.f, 0.f, 0.f, 0.f};
        cur = nxt; cA = nA; cB = nB; ++ui;
        if constexpr (ALIGN_EPI) { if (wr == 1) PG8_BAR; }
    }
    PG8_WAIT_V(0);
    if constexpr (!ALIGN_EPI) { if (wr == 0) PG8_BAR; }
    PG8_BAR;
    if constexpr (Epi::AFTER_DRAIN) { E.fused(acc, cur, wr, wc, fr, fq, lds, wid, lane); S.done(cur); }
#undef PG8_SA
#undef PG8_SB
#undef PG8_STAGE
#undef PG8_LDA
#undef PG8_LDB
#undef PG8_MMA
#undef PG8_WAIT_V
#undef PG8_WAIT_L
#undef PG8_BAR
#undef PG8_SCHED
}
}
namespace att {
typedef unsigned short bf16;
typedef short bf16x8 __attribute__((ext_vector_type(8)));
typedef short s16x4 __attribute__((ext_vector_type(4)));
typedef float f32x16 __attribute__((ext_vector_type(16)));
typedef float f32x4 __attribute__((ext_vector_type(4)));
typedef unsigned u32x4 __attribute__((ext_vector_type(4)));
constexpr int NW = 8, QBLK = 32, KVBLK = 64, QB = NW * QBLK;
constexpr int SHM_V = KVBLK * 128 * 2;
constexpr float THR = 8.f;
struct CfgA { static constexpr bool EXT = false, SK = true, LSEOUT = true; static constexpr float SCALE = 0.08838834764831845f; };
struct CfgB { static constexpr bool EXT = true, SK = false, LSEOUT = false; static constexpr float SCALE = 0.07216878364870322f; };
template <class C> struct Geo { static constexpr int KROW = C::EXT ? 384 : 256, SHM_K = KVBLK * KROW;
    static constexpr int OFF_K = 2 * SHM_V, OFF_WS = OFF_K + 2 * SHM_K, OFF_QR = OFF_WS + NW * 64 * 4, LDS_BYTES = OFF_QR + (C::EXT ? NW * 4096 : 0); };
#define SBAR() __builtin_amdgcn_sched_barrier(0)
__device__ __forceinline__ int v_st(int k, int c) { const int kk = (k & ~0xC) | ((k & 4) << 1) | ((k & 8) >> 1); return ((kk >> 3) * 4 + (c >> 5)) * 512 + ((kk & 7) * 32 + (c & 31)) * 2; }
__device__ __forceinline__ int v_rd_base(int lane) { return ((lane & 3) << 3) | (((lane >> 2) & 3) << 6) | (((lane >> 4) & 1) << 5) | (((lane >> 5) & 1) << 8); }
constexpr int v_rd_off(int d0, int ks, int half) { return d0 * 512 + ks * 4096 + half * 2048; }
__device__ __forceinline__ int crow(int r, int hi) { return (r & 3) + 8 * (r >> 2) + 4 * hi; }
__device__ __forceinline__ unsigned cvtpk(float lo, float hi) { unsigned r; asm volatile("v_cvt_pk_bf16_f32 %0, %1, %2" : "=v"(r) : "v"(lo), "v"(hi)); return r; }
__device__ __forceinline__ bf16x8 load8(const bf16* p) { return *reinterpret_cast<const bf16x8*>(p); }
__device__ __forceinline__ void mask_tile(f32x16& p0, f32x16& p1, int dq, unsigned W) {
    const float NEG = -__builtin_inff();
#pragma unroll
    for (int r = 0; r < 16; ++r) {
        const int c = (r & 3) + 8 * (r >> 2);
        if ((unsigned)(dq - c) >= W) p0[r] = NEG;
        if ((unsigned)(dq - c - 32) >= W) p1[r] = NEG;
    }
}
template <class C>
__device__ __forceinline__ void partialSM(f32x16& p0, f32x16& p1, float& m_reg, float& mn, float& alpha) {
    constexpr float SCALE = C::SCALE;
    float pmax = p0[0];
#pragma unroll
    for (int r = 1; r < 16; ++r) pmax = fmaxf(pmax, p0[r]);
#pragma unroll
    for (int r = 0; r < 16; ++r) pmax = fmaxf(pmax, p1[r]);
    { auto rr = __builtin_amdgcn_permlane32_swap(__float_as_uint(pmax), __float_as_uint(pmax), false, false);
      pmax = fmaxf(__uint_as_float(rr[0]), __uint_as_float(rr[1])); }
    constexpr float C2 = 1.4426950408889634f * SCALE;
    if (__builtin_expect(__all((pmax - m_reg) * SCALE <= THR), 1)) { mn = m_reg; alpha = 1.f; }
    else { mn = fmaxf(m_reg, pmax); alpha = __builtin_amdgcn_exp2f((m_reg - mn) * C2); m_reg = mn; }
    const float mnL = -mn * C2;
#pragma unroll
    for (int r = 0; r < 16; ++r) p0[r] = fmaf(p0[r], C2, mnL);
#pragma unroll
    for (int r = 0; r < 16; ++r) p1[r] = fmaf(p1[r], C2, mnL);
#pragma unroll
    for (int r = 0; r < 16; ++r) p0[r] = __builtin_amdgcn_exp2f(p0[r]);
}
__device__ __forceinline__ void finishSM(f32x16& p0, f32x16& p1, float alpha, float& l_reg, bf16x8& pa0, bf16x8& pa1, bf16x8& pa2, bf16x8& pa3) {
#pragma unroll
    for (int r = 0; r < 16; ++r) p1[r] = __builtin_amdgcn_exp2f(p1[r]);
    float ps = 0;
#pragma unroll
    for (int r = 0; r < 16; ++r) ps += p0[r];
#pragma unroll
    for (int r = 0; r < 16; ++r) ps += p1[r];
    { auto rr = __builtin_amdgcn_permlane32_swap(__float_as_uint(ps), __float_as_uint(ps), false, false);
      ps = __uint_as_float(rr[0]) + __uint_as_float(rr[1]); }
    l_reg = l_reg * alpha + ps;
#define PK4(P, B_, OUT) do { unsigned a0 = cvtpk(P[B_+0], P[B_+1]), a1 = cvtpk(P[B_+2], P[B_+3]);                          \
        unsigned b0 = cvtpk(P[B_+4], P[B_+5]), b1 = cvtpk(P[B_+6], P[B_+7]);                                             \
        auto r0 = __builtin_amdgcn_permlane32_swap(a0, b0, false, false); auto r1 = __builtin_amdgcn_permlane32_swap(a1, b1, false, false); \
        u32x4 w = {r0[0], r1[0], r0[1], r1[1]}; OUT = *reinterpret_cast<bf16x8*>(&w); } while (0)
    PK4(p0, 0, pa0); PK4(p0, 8, pa1); PK4(p1, 0, pa2); PK4(p1, 8, pa3);
#undef PK4
}
#define KSWZ(row, colB) ((row) * KROW + ((colB) ^ (((row) & 7) << 4)))
template <class C, int KB>
__device__ __forceinline__ void qkt(f32x16& p0, f32x16& p1, const char* K_lds, const char* QR_w, int lane, int r32, int hi, const bf16x8* qr, bool act) {
    constexpr int KROW = Geo<C>::KROW, SHM_K = Geo<C>::SHM_K;
    if (C::SK && !act) { const float NEG = -__builtin_inff();
#pragma unroll
        for (int r = 0; r < 16; ++r) { p0[r] = NEG; p1[r] = NEG; } return; }
    p0 = f32x16{}; p1 = f32x16{};
    const char* kb[4];
#pragma unroll
    for (int dd = 0; dd < 4; ++dd) kb[dd] = K_lds + KB * SHM_K + KSWZ(r32, (dd * 16 + hi * 8) * 2);
#pragma unroll
    for (int d0 = 0; d0 < 8; ++d0) { const char* a = kb[d0 & 3] + (d0 >> 2) * 128;
        bf16x8 b0 = *reinterpret_cast<const bf16x8*>(a);
        bf16x8 b1 = *reinterpret_cast<const bf16x8*>(a + 32 * KROW);
        p0 = __builtin_amdgcn_mfma_f32_32x32x16_bf16(b0, qr[d0], p0, 0, 0, 0);
        p1 = __builtin_amdgcn_mfma_f32_32x32x16_bf16(b1, qr[d0], p1, 0, 0, 0); }
    if constexpr (C::EXT) {
#pragma unroll
        for (int d0 = 0; d0 < 4; ++d0) { const char* a = kb[d0] + 256;
            bf16x8 b0 = *reinterpret_cast<const bf16x8*>(a);
            bf16x8 b1 = *reinterpret_cast<const bf16x8*>(a + 32 * KROW);
            bf16x8 qf = *reinterpret_cast<const bf16x8*>(QR_w + (d0 * 64 + lane) * 16);
            p0 = __builtin_amdgcn_mfma_f32_32x32x16_bf16(b0, qf, p0, 0, 0, 0);
            p1 = __builtin_amdgcn_mfma_f32_32x32x16_bf16(b1, qf, p1, 0, 0, 0); }
    }
}
template <class C, int VB>
__device__ __forceinline__ void pv_tile(f32x16* o, int vb0, bf16x8 pa0, bf16x8 pa1, bf16x8 pa2, bf16x8 pa3, bool act) {
    if (C::SK && !act) return;
#define TRRD(dst, off) asm volatile("ds_read_b64_tr_b16 %0, %1 offset:%2" : "=&v"(dst) : "v"(vb0), "i"(off) : "memory")
#define PV_D0(d0) do { s16x4 l0, l1, l2, l3, h0, h1, h2, h3; constexpr int b_ = VB * SHM_V + v_rd_off(d0, 0, 0); \
        TRRD(l0, b_); TRRD(h0, b_ + 2048); TRRD(l1, b_ + 4096); TRRD(h1, b_ + 6144); TRRD(l2, b_ + 8192); TRRD(h2, b_ + 10240); TRRD(l3, b_ + 12288); TRRD(h3, b_ + 14336); \
        asm volatile("s_waitcnt lgkmcnt(0)" ::: "memory"); SBAR();   \
        o[d0] = __builtin_amdgcn_mfma_f32_32x32x16_bf16(pa0, (bf16x8){l0[0], l0[1], l0[2], l0[3], h0[0], h0[1], h0[2], h0[3]}, o[d0], 0, 0, 0);   \
        o[d0] = __builtin_amdgcn_mfma_f32_32x32x16_bf16(pa1, (bf16x8){l1[0], l1[1], l1[2], l1[3], h1[0], h1[1], h1[2], h1[3]}, o[d0], 0, 0, 0);   \
        o[d0] = __builtin_amdgcn_mfma_f32_32x32x16_bf16(pa2, (bf16x8){l2[0], l2[1], l2[2], l2[3], h2[0], h2[1], h2[2], h2[3]}, o[d0], 0, 0, 0);   \
        o[d0] = __builtin_amdgcn_mfma_f32_32x32x16_bf16(pa3, (bf16x8){l3[0], l3[1], l3[2], l3[3], h3[0], h3[1], h3[2], h3[3]}, o[d0], 0, 0, 0); } while (0)
    PV_D0(0); PV_D0(1); PV_D0(2); PV_D0(3);
#undef PV_D0
#undef TRRD
}
struct Tens { bf16* QN; bf16* QR; bf16* KN; bf16* KR; bf16* VB; bf16* OC; };
struct Blk { bf16* base; float* lse; int P0, ld, ldl, row0, hd; };
template <class C> __device__ __forceinline__ const bf16* q_row0(const Blk& b, const Tens& T) { if constexpr (C::EXT) return T.QN + (size_t)(b.row0 + b.P0) * 2048 + b.hd * 128; else return b.base + (size_t)b.P0 * b.ld; }
template <class C> __device__ __forceinline__ bf16* o_row0(const Blk& b, const Tens& T) { if constexpr (C::EXT) return T.OC + (size_t)(b.row0 + b.P0) * 2048 + b.hd * 128; else return b.base + (size_t)b.P0 * b.ld; }
template <class C> __device__ __forceinline__ const bf16* k_row0(const Blk& b, const Tens& T) { if constexpr (C::EXT) return T.KN + (size_t)b.row0 * 2048 + b.hd * 128; else return b.base + 2048; }
template <class C> __device__ __forceinline__ const bf16* v_row0(const Blk& b, const Tens& T) { if constexpr (C::EXT) return T.VB + (size_t)b.row0 * 2048 + b.hd * 128; else return b.base + 4096; }
template <class C> __device__ __forceinline__ int ld_of(const Blk& b) { if constexpr (C::EXT) return 2048; else return b.ld; }
__device__ __forceinline__ int swa_jlo(int P0, int W) { const int lowk = P0 - W + 1; return lowk > 0 ? lowk / KVBLK : 0; }
#define VMW() asm volatile("s_waitcnt vmcnt(0)" ::: "memory")
template <class C>
__device__ __forceinline__ void attn_block(const Blk& cur, const Tens& T, int skv, int W, char* lds) {
    constexpr int KROW = Geo<C>::KROW, SHM_K = Geo<C>::SHM_K; constexpr bool SK = C::SK; constexpr float SCALE = C::SCALE;
    int tid_ = threadIdx.x; asm volatile("" : "+v"(tid_));
    const int tid = tid_, wid = __builtin_amdgcn_readfirstlane(tid >> 6), lane = tid & 63, r32 = lane & 31, hi = lane >> 5;
    const int j_lo = swa_jlo(cur.P0, W);
    int j_hi = (cur.P0 + QB - 1) / KVBLK + 1; if (j_hi > skv / KVBLK) j_hi = skv / KVBLK;
    const int NT = j_hi - j_lo;
    const int qlo = cur.P0 + wid * QBLK, qm = qlo + r32 - 4 * hi;
    char* V_lds = lds; char* K_lds = lds + Geo<C>::OFF_K;
    float* ws = (float*)(lds + Geo<C>::OFF_WS) + wid * 64; float* li_l = ws, * al_l = ws + 32;
    char* QR_w = lds + Geo<C>::OFF_QR + wid * 4096;
    const int sr = tid >> 4, sc = (tid & 15) * 8, vst0 = v_st(sr, sc), vst1 = v_st(32 + sr, sc), kws = KSWZ(sr, sc * 2);
    const int rr8 = tid >> 3, rc8 = (tid & 7) * 8, kwr = KSWZ(rr8, 256 + rc8 * 2);
    (void)kwr; (void)rr8; (void)rc8; (void)QR_w;
    const int vb0 = (int)(uintptr_t)V_lds + v_rd_base(lane);
    const bf16* kp = k_row0<C>(cur, T); const bf16* vp = v_row0<C>(cur, T); const int ld = ld_of<C>(cur);
    bf16x8 st_v0, st_v1, st_k0, st_k1, st_kr;
#define KBASE(t) ((j_lo + (t)) * KVBLK)
#define ACT(t) (KBASE(t) <= qlo + QBLK - 1 && KBASE(t) + KVBLK - 1 >= qlo - W + 1)
#define SLOAD(k0) do { st_v0 = load8(vp + (size_t)((k0) + sr) * ld + sc); st_v1 = load8(vp + (size_t)((k0) + 32 + sr) * ld + sc); \
                       st_k0 = load8(kp + (size_t)((k0) + sr) * ld + sc); st_k1 = load8(kp + (size_t)((k0) + 32 + sr) * ld + sc); \
                       if constexpr (C::EXT) st_kr = load8(T.KR + (size_t)(cur.row0 + (k0) + rr8) * 64 + rc8); } while (0)
#define SWRITE(bf) do { *(bf16x8*)(V_lds + (bf) * SHM_V + vst0) = st_v0; *(bf16x8*)(V_lds + (bf) * SHM_V + vst1) = st_v1; \
                        *(bf16x8*)(K_lds + (bf) * SHM_K + kws) = st_k0; *(bf16x8*)(K_lds + (bf) * SHM_K + kws + 32 * KROW) = st_k1; \
                        if constexpr (C::EXT) *(bf16x8*)(K_lds + (bf) * SHM_K + kwr) = st_kr; } while (0)
    bf16x8 qr[8];
    { const bf16* qp = q_row0<C>(cur, T) + (size_t)(wid * QBLK + r32) * ld + hi * 8;
#pragma unroll
      for (int d0 = 0; d0 < 8; ++d0) qr[d0] = load8(qp + d0 * 16); }
    if constexpr (C::EXT) {
#pragma unroll
        for (int d0 = 0; d0 < 4; ++d0) { const bf16x8 t = load8(T.QR + (size_t)(cur.row0 + cur.P0 + wid * QBLK + r32) * 1024 + cur.hd * 64 + d0 * 16 + hi * 8); *(bf16x8*)(QR_w + (d0 * 64 + lane) * 16) = t; }
    }
    SLOAD(KBASE(0)); VMW(); SWRITE(0);
    __syncthreads();
    float m_reg = -1e30f, l_reg = 0; f32x16 o[4] = {};
    f32x16 p0, p1; float mn, al; bf16x8 pa0, pa1, pa2, pa3;
#define STEP(t, BUF) do {                                                                                                     \
        if ((t) + 1 < NT) { SLOAD(KBASE((t) + 1)); }                                                                          \
        SBAR(); qkt<C, BUF>(p0, p1, K_lds, QR_w, lane, r32, hi, qr, ACT(t));                                                  \
        { const int kb_ = KBASE(t); if ((!SK || ACT(t)) && (kb_ + KVBLK - 1 > qlo || kb_ <= qlo + QBLK - 1 - W)) mask_tile(p0, p1, qm - kb_, (unsigned)W); } \
        partialSM<C>(p0, p1, m_reg, mn, al);                                                                                  \
        if (__any(al < 1.f)) { if (hi == 0) al_l[r32] = al; asm volatile("s_waitcnt lgkmcnt(0)" ::: "memory");              \
            for (int d_ = 0; d_ < 4; ++d_) for (int r = 0; r < 16; ++r) o[d_][r] *= al_l[crow(r, hi)]; }                      \
        finishSM(p0, p1, al, l_reg, pa0, pa1, pa2, pa3); SBAR();                                                              \
        pv_tile<C, BUF>(o, vb0, pa0, pa1, pa2, pa3, ACT(t));                                                                  \
        if ((t) + 1 < NT) { VMW(); SWRITE((BUF) ^ 1); }                                                                       \
        __syncthreads(); } while (0)
    for (int t = 0; t < NT; t += 2) {
        STEP(t, 0);
        if (t + 1 < NT) STEP(t + 1, 1);
    }
    if (hi == 0) li_l[r32] = l_reg; asm volatile("s_waitcnt lgkmcnt(0)" ::: "memory");
    if constexpr (C::LSEOUT) { if (hi == 0) cur.lse[(size_t)(cur.P0 + wid * QBLK + r32) * cur.ldl] = m_reg * SCALE + __logf(l_reg); }
    float rli[16];
#pragma unroll
    for (int r = 0; r < 16; ++r) rli[r] = __builtin_amdgcn_rcpf(li_l[crow(r, hi)]);
    bf16* Ow = o_row0<C>(cur, T) + (size_t)(wid * QBLK) * ld;
#pragma unroll
    for (int r = 0; r < 16; ++r) { const int orow = crow(r, hi);
#pragma unroll
        for (int d0 = 0; d0 < 4; ++d0) { const float v = o[d0][r] * rli[r];
            const float vn = __shfl_xor(v, 1);
            if ((r32 & 1) == 0) *(unsigned*)(Ow + (size_t)orow * ld + d0 * 32 + r32) = cvtpk(v, vn); } }
    __syncthreads();
#undef KBASE
#undef ACT
#undef SLOAD
#undef SWRITE
#undef STEP
}
#undef VMW
#undef KSWZ
#undef SBAR
}
#define GAS __attribute__((address_space(1)))
#define LAS __attribute__((address_space(3)))
typedef unsigned short bf16;
typedef unsigned v4u __attribute__((ext_vector_type(4)));
typedef float f32x4 __attribute__((ext_vector_type(4)));
typedef short bf16x8 __attribute__((ext_vector_type(8)));
typedef GAS unsigned gu32;
typedef GAS unsigned long long gu64;
#define RLX_AGENT __ATOMIC_RELAXED, __HIP_MEMORY_SCOPE_AGENT
#define LDS_WAIT() asm volatile("s_waitcnt lgkmcnt(0)" ::: "memory")
#define VM_WAIT() asm volatile("s_waitcnt vmcnt(0)" ::: "memory")
__device__ __forceinline__ unsigned long long rt() { return __builtin_amdgcn_s_memrealtime(); }
__device__ __forceinline__ unsigned f2bf(float f) { unsigned u = __builtin_bit_cast(unsigned, f); return (u + 0x7fffu + ((u >> 16) & 1u)) >> 16; }
__device__ __forceinline__ unsigned pk2(float lo, float hi) { return f2bf(lo) | (f2bf(hi) << 16); }

#define XB_TMO      128
#define XB_XCNT(j)  (256  + 64 * (j))
#define XB_XSUB(j)  (1280 + 64 * (j))
#define XB_XGEN(j)  (2304 + 64 * (j))
#define XB_TOP      3328
#define XB_TOPGEN   3392
#define XCD_BAR_WORDS 3456
#define XB_SPIN_CAP (1u << 18)

__device__ __forceinline__ unsigned xb_ld(unsigned* p)              { return __hip_atomic_load(p, __ATOMIC_RELAXED, __HIP_MEMORY_SCOPE_AGENT); }
__device__ __forceinline__ unsigned xb_add(unsigned* p, unsigned v) { return __hip_atomic_fetch_add(p, v, __ATOMIC_RELAXED, __HIP_MEMORY_SCOPE_AGENT); }
__device__ __forceinline__ unsigned xb_xcc_id() { return (unsigned)__builtin_amdgcn_s_getreg((3 << 11) | 20) & 0xFu; }
#define XB_SPIN(cond, bar) do { unsigned _sp = 0; while (cond) { __builtin_amdgcn_s_sleep(1); \
    if ((++_sp & 255u) == 0u) { if (xb_ld(&(bar)[XB_TMO])) break; if (_sp > XB_SPIN_CAP) { atomicAdd(&(bar)[XB_TMO], 1u); break; } } } } while (0)

struct XcdBarrier {
    unsigned* bar; unsigned x;
    volatile LAS unsigned* st;
};

__device__ __forceinline__ XcdBarrier xcd_barrier_post(unsigned* bar, volatile LAS unsigned* st) {
    XcdBarrier b; b.bar = bar; b.x = xb_xcc_id(); b.st = st;
    if (threadIdx.x == 0) (void)xb_add(&bar[XB_XCNT(b.x)], 1u);
    return b;
}
__device__ __forceinline__ void xcd_barrier_complete(unsigned* bar, unsigned x, unsigned& nloc, unsigned& nx) {
    const unsigned G = gridDim.x * gridDim.y * gridDim.z;
    unsigned sum, cnt, mine, sp = 0u;
    for (;;) {
        sum = 0u; cnt = 0u; mine = 0u;
#pragma unroll
        for (unsigned j = 0; j < 16; ++j) { const unsigned c = xb_ld(&bar[XB_XCNT(j)]); sum += c; cnt += (c > 0u) ? 1u : 0u; mine = (j == x) ? c : mine; }
        if (sum == G) break;
        __builtin_amdgcn_s_sleep(1);
        if ((++sp & 255u) == 0u) { if (xb_ld(&bar[XB_TMO])) break; if (sp > XB_SPIN_CAP) { atomicAdd(&bar[XB_TMO], 1u); break; } }
    }
    nloc = mine > 0u ? mine : 1u; nx = cnt > 0u ? cnt : 1u;
}

__device__ __forceinline__ void xcd_barrier(const XcdBarrier& b) {
    asm volatile("s_waitcnt vmcnt(0)" ::: "memory");
    __syncthreads();
    if (threadIdx.x == 0) {
        unsigned* bar = b.bar;
        __builtin_amdgcn_s_waitcnt(0);
        unsigned nloc = b.st[0], nx = b.st[1];
        if (nloc == 0u) { xcd_barrier_complete(bar, b.x, nloc, nx); b.st[0] = nloc; b.st[1] = nx; }
        const unsigned old = xb_add(&bar[XB_XSUB(b.x)], 1u);
        const unsigned gen = old / nloc;
        if (old + 1u == (gen + 1u) * nloc) {
            __builtin_amdgcn_fence(__ATOMIC_RELEASE, "agent");
            asm volatile("s_waitcnt vmcnt(0)" ::: "memory");
            const unsigned og = xb_add(&bar[XB_TOP], 1u);
            const unsigned tg = og / nx;
            if (og + 1u == (tg + 1u) * nx) xb_add(&bar[XB_TOPGEN], 1u);
            else XB_SPIN(xb_ld(&bar[XB_TOPGEN]) == tg, bar);
            __builtin_amdgcn_fence(__ATOMIC_ACQUIRE, "agent");
            xb_add(&bar[XB_XGEN(b.x)], 1u);
            asm volatile("s_waitcnt vmcnt(0)" ::: "memory");
        } else {
            XB_SPIN(xb_ld(&bar[XB_XGEN(b.x)]) == gen, bar);
            __builtin_amdgcn_fence(__ATOMIC_ACQUIRE, "agent");
            asm volatile("s_waitcnt vmcnt(0)" ::: "memory");
        }
    }
    __syncthreads();
}
#ifndef EN_CONV
#define EN_CONV 1
#endif
#ifndef EN_F1
#define EN_F1 1
#endif
#ifndef EN_F2
#define EN_F2 1
#endif
#ifndef EN_A1
#define EN_A1 1
#endif
#ifndef EN_A2
#define EN_A2 1
#endif
#ifndef EN_A3
#define EN_A3 1
#endif
#ifndef EN_B1
#define EN_B1 1
#endif
#ifndef EN_B23
#define EN_B23 1
#endif
#ifndef EN_B4
#define EN_B4 1
#endif
#ifndef EN_C1
#define EN_C1 1
#endif
#ifndef EN_C2
#define EN_C2 1
#endif
#ifndef EN_OUT
#define EN_OUT 1
#endif
constexpr int NWAVES = 8;
#ifndef MK_PER_PHASE
#define MK_PER_PHASE 0
#endif
constexpr int BATCH = 2, SEQ = 8192, DM = 2048, DFF = 5632, M = BATCH * SEQ;
constexpr int NQKV = 18432;
constexpr int BQ = 1536, BKV = 512, BR = 64, BIN_PAD = 2304;
constexpr size_t MiB = 1u << 20;
constexpr size_t WS_CTL = 0, CTL_ZERO_BYTES = 1 * MiB;
constexpr size_t WS_COSA = 1 * MiB, WS_SINA = 2 * MiB, WS_COSB = 3 * MiB, WS_SINB = 5 * MiB;
constexpr size_t WS_SS = 7 * MiB, WS_SSQ = 9 * MiB, WS_SSKV = 11 * MiB, WS_LSE = 12 * MiB;
constexpr size_t WS_H32 = 16 * MiB, WS_HB = 144 * MiB, WS_OC = 208 * MiB, WS_BIG = 272 * MiB, WS_W = 848 * MiB, WS_END = 1076 * MiB;
constexpr size_t BG_CQ = 0, BG_CKV = 48 * MiB, BG_KR = 64 * MiB, BG_QN = 66 * MiB, BG_QR = 130 * MiB, BG_KN = 162 * MiB, BG_VB = 226 * MiB;
constexpr size_t BG_CU = 0, BG_BGATE = 64 * MiB;
constexpr size_t WE_13A = 0, WE_2A = 23068672, WE_13B = 34603008, WE_2B = 57671680, WE_MIX0 = 69206016, WE_MIX1 = 106954752, WE_MIX2 = 111673344, WE_MIX3 = 113770496, WE_END = 117964800;
static_assert(WS_W + WE_END * 2 <= WS_END, "weights fit");
constexpr int CW_BAR = 4096;
constexpr int RING_OFF = 0, RING_BYTES = 131072;
constexpr int LDSCTL_OFF = RING_BYTES, MISC_OFF = LDSCTL_OFF + 320;
constexpr int LDS_BYTES = 147456;
static_assert(att::Geo<att::CfgB>::LDS_BYTES <= RING_BYTES && att::Geo<att::CfgA>::LDS_BYTES <= RING_BYTES, "attention LDS fits the ring");

struct Args { const float* in[44]; float* out; unsigned char* ws; float invA[16]; float invB[32]; int ph_lo, ph_hi, use_bar, pad; };

__device__ __forceinline__ int layer_base(int L) { return L == 0 ? 2 : (L == 1 ? 11 : (L == 2 ? 24 : 34)); }
__device__ __forceinline__ float wave_sum(float v) {
#pragma unroll
    for (int o = 1; o < 64; o <<= 1) v += __shfl_xor(v, o);
    return v;
}
enum { MAP_ID = 0, MAP_FFN = 1, MAP_AQKV = 2, MAP_BIN = 3, MAP_BUQ = 4, MAP_CIN = 5 };
__device__ __forceinline__ int map_col(int kind, int n) {
    switch (kind) {
    case MAP_FFN:  { const int pn = n >> 8, bj = (n >> 7) & 1, j = n & 127; return bj * DFF + pn * 128 + j; }
    case MAP_AQKV: { const int d = n & 127, t = (n >> 11) % 3; if (t < 2 && d < 32) { const int fqq = d >> 3, r = d & 7; return (n - d) + (r < 4 ? 4 * fqq + r : 16 + 4 * fqq + (r - 4)); } return n; }
    case MAP_BIN:  { if (n < 2048) return n; const int c = n - 2048; if (c < 32) return 2048 + c; if (c >= 128 && c < 160) return 2048 + 32 + (c - 128); return -1; }
    case MAP_BUQ:  { if (n < 2048) { const int head = n >> 7, d = n & 127; return head * 192 + d; } const int tt = (n - 2048) >> 8, bj = (n >> 7) & 1, c = n & 127; return (tt * 4 + (c >> 5)) * 192 + 128 + (c & 31) + 32 * bj; }
    case MAP_CIN:  { if (n < 4096) { const int pn = n >> 8, bj = (n >> 7) & 1, j = n & 127; return 2048 + bj * 2048 + pn * 128 + j; } return n - 4096; }
    default: return n;
    }
}
__device__ __forceinline__ void conv_item(const float* W, int K, int Nsrc, bf16* WT, int Ndst, int kind, const float* gain, LAS float* scr, int item, int lane) {
    const int nblk = Ndst >> 5, kb = item / nblk, nb = item - kb * nblk, k0 = 64 * kb, n0 = 32 * nb;
    const int scol = map_col(kind, n0 + (lane & 31));
    const float* src = W + (size_t)(k0 + (lane >> 5)) * Nsrc + (scol < 0 ? 0 : scol);
#pragma unroll 8
    for (int i = 0; i < 32; ++i) { float v = src[(size_t)(2 * i) * Nsrc]; if (scol < 0) v = 0.f; scr[(2 * i + (lane >> 5)) * 33 + (lane & 31)] = v; }
    LDS_WAIT(); asm volatile("" ::: "memory");
    const int c = lane & 7;
    f32x4 g0 = {1.f, 1.f, 1.f, 1.f}, g1 = {1.f, 1.f, 1.f, 1.f};
    if (gain) { g0 = *(const f32x4*)(gain + k0 + 8 * c); g1 = *(const f32x4*)(gain + k0 + 8 * c + 4); }
#pragma unroll
    for (int j = 0; j < 4; ++j) { const int n = (lane >> 3) + 8 * j; const LAS float* s = scr + (8 * c) * 33 + n;
        v4u o; o.x = pk2(s[0 * 33] * g0[0], s[1 * 33] * g0[1]); o.y = pk2(s[2 * 33] * g0[2], s[3 * 33] * g0[3]); o.z = pk2(s[4 * 33] * g1[0], s[5 * 33] * g1[1]); o.w = pk2(s[6 * 33] * g1[2], s[7 * 33] * g1[3]);
        *(v4u*)(WT + (size_t)(n0 + n) * K + k0 + 8 * c) = o; }
    LDS_WAIT(); asm volatile("" ::: "memory");
}
__device__ __forceinline__ int conv_job(const float* W, int K, int Nsrc, bf16* WT, int Ndst, int kind, const float* gain, LAS float* scr, int lane, int gw, int NGW, int base) {
    const int nitems = (K >> 6) * (Ndst >> 5);
    int first = (gw - base) % NGW; if (first < 0) first += NGW;
    for (int it = first; it < nitems; it += NGW) conv_item(W, K, Nsrc, WT, Ndst, kind, gain, scr, it, lane);
    return base + nitems;
}
#define CONV_LAYER(L_) do { int lane_ = lane; asm volatile("" : "+v"(lane_)); const int li_ = layer_base(L_), kind_ = (L_) % 3, n2_ = li_ + (kind_ == 0 ? 6 : (kind_ == 1 ? 10 : 7)); int b_ = 0; \
    b_ = conv_job(args.in[li_ + 1], DM, 2 * DFF, WB + WE_13A, 2 * DFF, MAP_FFN, args.in[li_], scr, lane_, gw, NGW, b_); \
    b_ = conv_job(args.in[li_ + 2], DFF, DM, WB + WE_2A, DM, MAP_ID, nullptr, scr, lane_, gw, NGW, b_); \
    b_ = conv_job(args.in[n2_ + 1], DM, 2 * DFF, WB + WE_13B, 2 * DFF, MAP_FFN, args.in[n2_], scr, lane_, gw, NGW, b_); \
    b_ = conv_job(args.in[n2_ + 2], DFF, DM, WB + WE_2B, DM, MAP_ID, nullptr, scr, lane_, gw, NGW, b_); \
    if (kind_ == 0) { \
        b_ = conv_job(args.in[li_ + 4], DM, NQKV, WB + WE_MIX0, NQKV, MAP_AQKV, args.in[li_ + 3], scr, lane_, gw, NGW, b_); \
        b_ = conv_job(args.in[li_ + 5], DM, DM, WB + WE_MIX1, DM, MAP_ID, nullptr, scr, lane_, gw, NGW, b_); \
    } else if (kind_ == 1) { \
        b_ = conv_job(args.in[li_ + 4], DM, BQ + BKV + BR, WB + WE_MIX0, BIN_PAD, MAP_BIN, args.in[li_ + 3], scr, lane_, gw, NGW, b_); \
        b_ = conv_job(args.in[li_ + 6], BQ, 3072, WB + WE_MIX1, 3072, MAP_BUQ, args.in[li_ + 5], scr, lane_, gw, NGW, b_); \
        b_ = conv_job(args.in[li_ + 8], BKV, 4096, WB + WE_MIX2, 4096, MAP_ID, args.in[li_ + 7], scr, lane_, gw, NGW, b_); \
        b_ = conv_job(args.in[li_ + 9], DM, DM, WB + WE_MIX3, DM, MAP_ID, nullptr, scr, lane_, gw, NGW, b_); \
    } else { \
        b_ = conv_job(args.in[li_ + 4], DM, 3 * DM, WB + WE_MIX0, 3 * DM, MAP_CIN, args.in[li_ + 3], scr, lane_, gw, NGW, b_); \
        b_ = conv_job(args.in[li_ + 6], DM, DM, WB + WE_MIX1, DM, MAP_ID, nullptr, scr, lane_, gw, NGW, b_); \
    } (void)b_; } while (0)
__device__ __forceinline__ void sincos_d(double a, float& sn, float& cs) {
    const double k = __builtin_rint(a * 0.15915494309189533577);
    double r = __builtin_fma(-k, 6.28318530717958623200, a); r = __builtin_fma(-k, 2.4492935982947064e-16, r);
    const double r2 = r * r;
    double s = -1.0 / 51090942171709440000.0;
    s = s * r2 + 1.0 / 121645100408832000.0;
    s = s * r2 - 1.0 / 355687428096000.0;
    s = s * r2 + 1.0 / 1307674368000.0;
    s = s * r2 - 1.0 / 6227020800.0;
    s = s * r2 + 1.0 / 39916800.0;
    s = s * r2 - 1.0 / 362880.0;
    s = s * r2 + 1.0 / 5040.0;
    s = s * r2 - 1.0 / 120.0;
    s = s * r2 + 1.0 / 6.0;
    s = r - r * r2 * s;
    double c = 1.0 / 1124000727777607680000.0;
    c = c * r2 - 1.0 / 2432902008176640000.0;
    c = c * r2 + 1.0 / 6402373705728000.0;
    c = c * r2 - 1.0 / 20922789888000.0;
    c = c * r2 + 1.0 / 87178291200.0;
    c = c * r2 - 1.0 / 479001600.0;
    c = c * r2 + 1.0 / 3628800.0;
    c = c * r2 - 1.0 / 40320.0;
    c = c * r2 + 1.0 / 720.0;
    c = c * r2 - 1.0 / 24.0;
    c = c * r2 + 0.5;
    c = 1.0 - r2 * c;
    sn = (float)s; cs = (float)c;
}

__global__ void __launch_bounds__(NWAVES * 64, 2) mk_fwd(Args args) {
    extern __shared__ __attribute__((aligned(16))) unsigned char lds_raw[];
    LAS unsigned char* lds = (LAS unsigned char*)lds_raw;
    volatile LAS unsigned* MISC = (volatile LAS unsigned*)(lds + MISC_OFF);
    const int tid = threadIdx.x, lane = tid & 63, wave = __builtin_amdgcn_readfirstlane(tid >> 6);
    const int G = gridDim.x; const int bx = blockIdx.x; const int vcu = (G % 8 == 0) ? (bx % 8) * (G / 8) + bx / 8 : bx;
    const int gw = vcu * NWAVES + wave, NGW = G * NWAVES;
    unsigned char* ws = args.ws;
    unsigned* ctl = (unsigned*)(ws + WS_CTL);
    float* cosA = (float*)(ws + WS_COSA); float* sinA = (float*)(ws + WS_SINA); float* cosB = (float*)(ws + WS_COSB); float* sinB = (float*)(ws + WS_SINB);
    float* SS = (float*)(ws + WS_SS); float* SSQ = (float*)(ws + WS_SSQ); float* SSKV = (float*)(ws + WS_SSKV); float* LSE = (float*)(ws + WS_LSE);
    float* H32 = (float*)(ws + WS_H32); bf16* HB = (bf16*)(ws + WS_HB); bf16* OC = (bf16*)(ws + WS_OC);
    unsigned char* BIG = ws + WS_BIG; bf16* WB = (bf16*)(ws + WS_W);
    bf16* HID = (bf16*)BIG; bf16* QKV = (bf16*)BIG;
    for (int u = tid; u < (LDS_BYTES - LDSCTL_OFF) / 4; u += NWAVES * 64) ((LAS unsigned*)(lds + LDSCTL_OFF))[u] = 0u;
    __syncthreads();
    XcdBarrier bar; bar.bar = ctl + CW_BAR; bar.x = 0; bar.st = nullptr;
    if (args.use_bar) bar = xcd_barrier_post(ctl + CW_BAR, MISC + 8);
    const int lo = args.ph_lo, hi = args.ph_hi;
    int ph = 0;
#define IN_PH() (lo <= ph && ph < hi)
#define SEAM() do { if (lo <= ph && ph + 1 < hi) xcd_barrier(bar); ++ph; } while (0)
    LAS float* scr = (LAS float*)(lds + RING_OFF + wave * 16384);

    if (IN_PH()) {
        const float* x = args.in[0]; const int* pos = (const int*)args.in[1];
        for (int m = gw; m < M; m += NGW) {
            const f32x4* xr = (const f32x4*)(x + (size_t)m * DM) + lane; float s = 0.f;
            unsigned long long* o8 = (unsigned long long*)(HB + (size_t)m * DM) + lane;
#pragma unroll
            for (int j = 0; j < 8; ++j) { const f32x4 v = xr[64 * j]; s += (v[0] * v[0] + v[1] * v[1]) + (v[2] * v[2] + v[3] * v[3]);
                o8[64 * j] = (unsigned long long)pk2(v[0], v[1]) | ((unsigned long long)pk2(v[2], v[3]) << 32); }
            s = wave_sum(s);
            if (lane < 32) SS[(size_t)m * 32 + lane] = (lane == 0) ? s : 0.f;
        }
        for (int i = gw * 64 + lane; i < M * 48; i += NGW * 64) {
            const int m = i / 48, j = i - m * 48; const float p = (float)pos[m];
            if (j < 16) { const float ang = p * args.invA[j]; float sn, cs; sincos_d((double)ang, sn, cs); cosA[m * 16 + j] = cs; sinA[m * 16 + j] = sn; }
            else { const int jj = j - 16; const float ang = p * args.invB[jj]; float sn, cs; sincos_d((double)ang, sn, cs); cosB[m * 32 + jj] = cs; sinB[m * 32 + jj] = sn; }
        }
#if EN_CONV
        CONV_LAYER(0);
#endif
    }
    SEAM();

    for (int s = 0; s < 12; ++s) {
        const int L = s / 3, r = s - 3 * L, kind = L % 3;
        if (r == 0 && L > 0) {
#if EN_CONV
            if (IN_PH()) CONV_LAYER(L);
#endif
            SEAM(); }
        if (r != 1) {
#if EN_F1
            if (IN_PH()) { const bf16* ga_ = HB; const bf16* gb_ = WB + (r == 0 ? WE_13A : WE_13B); asm volatile("" : "+s"(ga_), "+s"(gb_)); pg8::Gemm g{ga_, gb_, M, 2 * DFF, DM}; pg8::StaticOrder S; S.init(M, 2 * DFF, G, bx);
                pg8::EpiSwiGLU E{HID, DFF, SS};
                pg8::gemm_phase<pg8::EpiSwiGLU, pg8::StaticOrder, true, true>(lds + RING_OFF, g, S, E); }
#endif
            SEAM();
#if EN_F2
            if (IN_PH()) { const bf16* ga_ = HID; const bf16* gb_ = WB + (r == 0 ? WE_2A : WE_2B); asm volatile("" : "+s"(ga_), "+s"(gb_)); pg8::Gemm g{ga_, gb_, M, DM, DFF}; pg8::StaticOrder S; S.init(M, DM, G, bx);
                pg8::EpiResid E{(s == 0) ? args.in[0] : (const float*)H32, H32, HB, SS, 0.5f};
                pg8::gemm_phase<pg8::EpiResid, pg8::StaticOrder, true, true>(lds + RING_OFF, g, S, E); }
#endif
            SEAM();
        } else {
            if (kind == 0) {
#if EN_A1
                if (IN_PH()) { const bf16* ga_ = HB; const bf16* gb_ = WB + WE_MIX0; asm volatile("" : "+s"(ga_), "+s"(gb_)); pg8::Gemm g{ga_, gb_, M, NQKV, DM}; pg8::StaticOrder S; S.init(M, NQKV, G, bx);
                    pg8::EpiQKVA E{QKV, SS, cosA, sinA};
                    pg8::gemm_phase<pg8::EpiQKVA, pg8::StaticOrder, true, true>(lds + RING_OFF, g, S, E); }
#endif
                SEAM();
#if EN_A2
                if (IN_PH()) {
                    att::Blk cur; att::Tens TT; TT.QN = nullptr; TT.QR = nullptr; TT.KN = nullptr; TT.KR = nullptr; TT.VB = nullptr; TT.OC = nullptr;
                    const int nblk = (3072 - bx + G - 1) / G;
#define ABLK(dst, Lx) do { const int L_ = (Lx); const int j_ = L_ & 31, hd_ = (L_ >> 5) & 15, bg_ = L_ >> 9, g_ = bg_ % 3, b_ = bg_ / 3; const int dil_ = (g_ == 0) ? 1 : (g_ == 1 ? 4 : 16), nqb_ = 32 / dil_; \
        const int c_ = j_ / nqb_, qb_ = j_ - c_ * nqb_; const size_t t0_ = (size_t)b_ * SEQ + c_; dst.base = QKV + t0_ * NQKV + g_ * 6144 + hd_ * 128; dst.ld = dil_ * NQKV; \
        dst.P0 = qb_ * 256; dst.ldl = dil_ * 16; dst.lse = LSE + (size_t)g_ * M * 16 + t0_ * 16 + hd_; dst.row0 = 0; dst.hd = 0; } while (0)
                    for (int i = 0; i < nblk; ++i) {
                        ABLK(cur, bx + i * G);
                        const int g_ = ((bx + i * G) >> 9) % 3; const int skv = (g_ == 0) ? 8192 : (g_ == 1 ? 2048 : 512);
                        att::attn_block<att::CfgA>(cur, TT, skv, 129, (char*)lds_raw + RING_OFF);
                    }
#undef ABLK
                }
#endif
                SEAM();
#if EN_A3
                if (IN_PH()) { int lane_ = lane; asm volatile("" : "+v"(lane_));
                    for (int m = gw; m < M; m += NGW) {
#pragma unroll
                        for (int j = 0; j < 4; ++j) { const int col = (j * 64 + lane_) * 8, hd = col >> 7;
                            const float l0 = LSE[(size_t)m * 16 + hd], l1 = LSE[(size_t)(M + m) * 16 + hd], l2 = LSE[(size_t)(2 * M + m) * 16 + hd];
                            const float mx = fmaxf(l0, fmaxf(l1, l2)); const float e0 = __expf(l0 - mx), e1 = __expf(l1 - mx), e2 = __expf(l2 - mx); const float inv = 1.0f / (e0 + e1 + e2);
                            const v4u a = *(const v4u*)(QKV + (size_t)m * NQKV + col), b = *(const v4u*)(QKV + (size_t)m * NQKV + 6144 + col), c = *(const v4u*)(QKV + (size_t)m * NQKV + 12288 + col);
                            v4u o;
#pragma unroll
                            for (int k = 0; k < 4; ++k) { const float alo = __uint_as_float(a[k] << 16), ahi = __uint_as_float(a[k] & 0xffff0000u), blo = __uint_as_float(b[k] << 16), bhi = __uint_as_float(b[k] & 0xffff0000u),
                                    clo = __uint_as_float(c[k] << 16), chi = __uint_as_float(c[k] & 0xffff0000u);
                                o[k] = pk2((alo * e0 + blo * e1 + clo * e2) * inv, (ahi * e0 + bhi * e1 + chi * e2) * inv); }
                            *(v4u*)(OC + (size_t)m * DM + col) = o; }
                    }
                }
#endif
                SEAM();
            } else if (kind == 1) {
                bf16* CQ = (bf16*)(BIG + BG_CQ); bf16* CKV = (bf16*)(BIG + BG_CKV); bf16* KR = (bf16*)(BIG + BG_KR); bf16* QN = (bf16*)(BIG + BG_QN); bf16* QRo = (bf16*)(BIG + BG_QR);
                bf16* KN = (bf16*)(BIG + BG_KN); bf16* VB = (bf16*)(BIG + BG_VB);
#if EN_B1
                if (IN_PH()) { const bf16* ga_ = HB; const bf16* gb_ = WB + WE_MIX0; asm volatile("" : "+s"(ga_), "+s"(gb_)); pg8::Gemm g{ga_, gb_, M, BIN_PAD, DM}; pg8::StaticOrder S; S.init(M, BIN_PAD, G, bx);
                    pg8::EpiBin E{CQ, CKV, KR, SSQ, SSKV, SS, cosB, sinB};
                    pg8::gemm_phase<pg8::EpiBin, pg8::StaticOrder, true, true>(lds + RING_OFF, g, S, E); }
#endif
                SEAM();
#if EN_B23
                if (IN_PH()) {
                    { const bf16* ga_ = CQ; const bf16* gb_ = WB + WE_MIX1; asm volatile("" : "+s"(ga_), "+s"(gb_)); pg8::Gemm g{ga_, gb_, M, 3072, BQ}; pg8::StaticOrder S; S.init(M, 3072, G, bx);
                      pg8::EpiUQ E{QN, QRo, SSQ, cosB, sinB};
                      pg8::gemm_phase<pg8::EpiUQ, pg8::StaticOrder, true, true>(lds + RING_OFF, g, S, E); }
                    { const bf16* ga_ = CKV; const bf16* gb_ = WB + WE_MIX2; asm volatile("" : "+s"(ga_), "+s"(gb_)); pg8::Gemm g{ga_, gb_, M, 4096, BKV}; pg8::StaticOrder S; S.init(M, 4096, G, bx);
                      pg8::EpiUKV E{KN, VB, SSKV};
                      pg8::gemm_phase<pg8::EpiUKV, pg8::StaticOrder, true, true>(lds + RING_OFF, g, S, E); }
                }
#endif
                SEAM();
#if EN_B4
                if (IN_PH()) {
                    att::Blk cur; att::Tens TT; TT.QN = QN; TT.QR = QRo; TT.KN = KN; TT.KR = KR; TT.VB = VB; TT.OC = OC;
                    const int nitem = (512 - bx + G - 1) / G, nblk = 2 * nitem;
#define BBLK(dst, ix) do { const int it_ = bx + ((ix) >> 1) * G, ps_ = (ix) & 1; const int bh_ = it_ >> 4, x_ = it_ & 15, qb_ = ps_ ? 31 - x_ : x_; \
        dst.row0 = (bh_ >> 4) * SEQ; dst.hd = bh_ & 15; dst.P0 = qb_ * 256; dst.base = nullptr; dst.lse = nullptr; dst.ld = 2048; dst.ldl = 0; } while (0)
                    for (int i = 0; i < nblk; ++i) {
                        BBLK(cur, i);
                        att::attn_block<att::CfgB>(cur, TT, SEQ, 1 << 30, (char*)lds_raw + RING_OFF);
                    }
#undef BBLK
                }
#endif
                SEAM();
            } else {
                bf16* CU = (bf16*)(BIG + BG_CU); bf16* BGt = (bf16*)(BIG + BG_BGATE);
#if EN_C1
                if (IN_PH()) { const bf16* ga_ = HB; const bf16* gb_ = WB + WE_MIX0; asm volatile("" : "+s"(ga_), "+s"(gb_)); pg8::Gemm g{ga_, gb_, M, 3 * DM, DM}; pg8::StaticOrder S; S.init(M, 3 * DM, G, bx);
                    pg8::EpiCin E{CU, BGt, SS};
                    pg8::gemm_phase<pg8::EpiCin, pg8::StaticOrder, true, true>(lds + RING_OFF, g, S, E); }
#endif
                SEAM();
#if EN_C2
                if (IN_PH()) { const float* cw = args.in[layer_base(L) + 5]; int lane_ = lane; asm volatile("" : "+v"(lane_));
                    for (int m = gw; m < M; m += NGW) { const int t = m & (SEQ - 1);
#pragma unroll
                        for (int j = 0; j < 4; ++j) { const int col = (j * 64 + lane_) * 8;
                            const v4u x2 = *(const v4u*)(CU + (size_t)m * DM + col); v4u x1 = {0u, 0u, 0u, 0u}, x0 = {0u, 0u, 0u, 0u};
                            if (t >= 1) x1 = *(const v4u*)(CU + (size_t)(m - 1) * DM + col);
                            if (t >= 2) x0 = *(const v4u*)(CU + (size_t)(m - 2) * DM + col);
                            const v4u bg = *(const v4u*)(BGt + (size_t)m * DM + col);
                            const f32x4 w0a = *(const f32x4*)(cw + col), w0b = *(const f32x4*)(cw + col + 4), w1a = *(const f32x4*)(cw + DM + col), w1b = *(const f32x4*)(cw + DM + col + 4),
                                        w2a = *(const f32x4*)(cw + 2 * DM + col), w2b = *(const f32x4*)(cw + 2 * DM + col + 4);
                            v4u o;
#pragma unroll
                            for (int k = 0; k < 4; ++k) { const float wl0 = (k < 2) ? w0a[2 * k] : w0b[2 * k - 4], wh0 = (k < 2) ? w0a[2 * k + 1] : w0b[2 * k - 3];
                                const float wl1 = (k < 2) ? w1a[2 * k] : w1b[2 * k - 4], wh1 = (k < 2) ? w1a[2 * k + 1] : w1b[2 * k - 3];
                                const float wl2 = (k < 2) ? w2a[2 * k] : w2b[2 * k - 4], wh2 = (k < 2) ? w2a[2 * k + 1] : w2b[2 * k - 3];
                                const float zl = wl0 * __uint_as_float(x0[k] << 16) + wl1 * __uint_as_float(x1[k] << 16) + wl2 * __uint_as_float(x2[k] << 16);
                                const float zh = wh0 * __uint_as_float(x0[k] & 0xffff0000u) + wh1 * __uint_as_float(x1[k] & 0xffff0000u) + wh2 * __uint_as_float(x2[k] & 0xffff0000u);
                                o[k] = pk2(zl * __uint_as_float(bg[k] << 16), zh * __uint_as_float(bg[k] & 0xffff0000u)); }
                            *(v4u*)(OC + (size_t)m * DM + col) = o; }
                    }
                }
#endif
                SEAM();
            }
#if EN_OUT
            if (IN_PH()) { const bf16* ga_ = OC; const bf16* gb_ = WB + ((kind == 1) ? WE_MIX3 : WE_MIX1); asm volatile("" : "+s"(ga_), "+s"(gb_)); pg8::Gemm g{ga_, gb_, M, DM, DM}; pg8::StaticOrder S; S.init(M, DM, G, bx);
                pg8::EpiResid E{H32, H32, HB, SS, 1.0f};
                pg8::gemm_phase<pg8::EpiResid, pg8::StaticOrder, true, true>(lds + RING_OFF, g, S, E); }
#endif
            SEAM();
        }
    }
    if (IN_PH()) { const float* gn = args.in[43];
        for (int m = gw; m < M; m += NGW) {
            float s = (lane < 32) ? SS[(size_t)m * 32 + lane] : 0.f; s = wave_sum(s);
            const float rs = 1.0f / sqrtf(s * (1.0f / 2048.0f) + 1e-6f);
            const f32x4* hr = (const f32x4*)(H32 + (size_t)m * DM) + lane; f32x4* orow = (f32x4*)(args.out + (size_t)m * DM) + lane; const f32x4* gr = (const f32x4*)gn + lane;
#pragma unroll
            for (int j = 0; j < 8; ++j) orow[64 * j] = hr[64 * j] * rs * gr[64 * j];
        }
    }
#undef IN_PH
#undef SEAM
}

constexpr int N_PHASES = 36;
extern "C" void kernel_launch(void* const* d_in, const int* in_sizes, int n_in, void* d_out, int out_size, void* d_ws, size_t ws_size, hipStream_t stream) {
    static int grid = 0;
    if (grid == 0) {
        if (n_in != 44 || in_sizes[0] != M * DM || out_size != M * DM || ws_size < WS_END) { fprintf(stderr, "kernel_launch: unexpected shapes (n_in %d, in0 %d, out %d, ws %zu); nothing launched\n", n_in, n_in > 0 ? in_sizes[0] : -1, out_size, ws_size); grid = -1; return; }
        int dev = 0, cus = 0, per_cu = 0;
        if (hipGetDevice(&dev) != hipSuccess || hipDeviceGetAttribute(&cus, hipDeviceAttributeMultiprocessorCount, dev) != hipSuccess) { grid = -1; return; }
        if (hipFuncSetAttribute((const void*)mk_fwd, hipFuncAttributeMaxDynamicSharedMemorySize, LDS_BYTES) != hipSuccess) { fprintf(stderr, "kernel_launch: hipFuncSetAttribute failed\n"); grid = -1; return; }
        if (hipOccupancyMaxActiveBlocksPerMultiprocessor(&per_cu, (const void*)mk_fwd, NWAVES * 64, LDS_BYTES) != hipSuccess || per_cu < 1) fprintf(stderr, "kernel_launch: occupancy query reports %d\n", per_cu);
        (void)hipGetLastError();
        grid = cus;
    }
    if (grid < 0) return;
    if (hipMemsetAsync((char*)d_ws + WS_CTL, 0, CTL_ZERO_BYTES, stream) != hipSuccess) return;
    Args a{};
    for (int i = 0; i < 44; ++i) a.in[i] = (const float*)d_in[i];
    a.out = (float*)d_out; a.ws = (unsigned char*)d_ws;
    for (int i = 0; i < 16; ++i) a.invA[i] = (float)pow(500000.0, -(double)i / 16.0);
    for (int i = 0; i < 32; ++i) a.invB[i] = (float)pow(500000.0, -(double)i / 32.0);
#if MK_PER_PHASE
    for (int p = 0; p < N_PHASES; ++p) { a.ph_lo = p; a.ph_hi = p + 1; a.use_bar = 0; a.pad = 0;
        hipLaunchKernelGGL(mk_fwd, dim3(grid), dim3(NWAVES * 64), LDS_BYTES, stream, a); }
#else
    a.ph_lo = 0; a.ph_hi = N_PHASES; a.use_bar = 1; a.pad = 0;
    hipLaunchKernelGGL(mk_fwd, dim3(grid), dim3(NWAVES * 64), LDS_BYTES, stream, a);
#endif
}
```

```cpp
#include <hip/hip_runtime.h>
#include <cstdio>
#include <cstdint>
#include <cmath>
#define RES_MODE 2
#define SKIPW_ON 1
__device__ __forceinline__ int hw_lane() { int l; asm volatile("v_mbcnt_lo_u32_b32 %0, -1, 0\n\tv_mbcnt_hi_u32_b32 %0, -1, %0" : "=v"(l)); return l; }
namespace pg8 {
#define PG8_LAS __attribute__((address_space(3)))
typedef unsigned short bf16_t;
typedef short bf16x8 __attribute__((ext_vector_type(8)));
typedef float f32x4 __attribute__((ext_vector_type(4)));
typedef unsigned u32x4 __attribute__((ext_vector_type(4)));
typedef int i32x4 __attribute__((ext_vector_type(4)));
typedef unsigned u32x2 __attribute__((ext_vector_type(2)));
constexpr int BM = 256, BK = 64, HALF = 128, HTB = HALF * BK * 2  , STAGE_BYTES = 8 * HTB, NXCD = 8, WGM = 8;

__host__ __device__ __forceinline__ int lds_byte(int r, int c) { const int st = (r >> 4) * 2 + (c >> 5), rr = r & 15, cc = c & 31, ob = rr * 64 + cc * 2; return st * 1024 + (ob ^ (((ob >> 9) & 1) << 5)); }
__host__ __device__ __forceinline__ void stage_rc(int b, int& R, int& C) { const int st = b / 1024, sb = b % 1024, swz = sb ^ (((sb >> 9) & 1) << 5); R = (st >> 1) * 16 + swz / 64; C = (st & 1) * 32 + (swz % 64) / 2; }
__host__ __device__ __forceinline__ int perm32(int rho) { const int n = rho >> 4, i = rho & 15; return 8 * (i >> 2) + 4 * n + (i & 3); }

struct Unit { int pm, pn; };
struct Gemm { const bf16_t* A; const bf16_t* Bt; int M, N, K; };

struct StaticOrder {
    int nM, nN, nwg, G, c, wgm;
    __host__ __device__ __forceinline__ void init(int M, int N, int G_, int c_, int wgm_ = WGM) { nM = M / BM; nN = N / BM; nwg = nM * nN; G = G_; c = c_; wgm = wgm_; }
    __host__ __device__ __forceinline__ bool next(int i, Unit& u) const {
        const long L = (long)i * G + c; if (L >= nwg) return false;
        int wgid = (int)L; { const int q = nwg / NXCD, r = nwg % NXCD, xcd = wgid % NXCD, off = wgid / NXCD; wgid = (xcd < r ? xcd * (q + 1) : r * (q + 1) + (xcd - r) * q) + off; }
        const int nig = wgm * nN, gid = wgid / nig, fm = gid * wgm, gsz = (nM - fm) < wgm ? (nM - fm) : wgm;
        u.pm = fm + ((wgid % nig) % gsz); u.pn = (wgid % nig) / gsz; return true;
    }
    __device__ __forceinline__ void a_ready(const Unit&) const {}
    __device__ __forceinline__ void done(const Unit&) const {}
};
__device__ __forceinline__ unsigned cvt_pk_bf16(float lo, float hi) { unsigned r; asm volatile("v_cvt_pk_bf16_f32 %0, %1, %2" : "=v"(r) : "v"(lo), "v"(hi)); return r; }
typedef float f32x2e __attribute__((ext_vector_type(2)));
constexpr float NORM_EPS = 1e-6f;
template <int NPF> __device__ __forceinline__ float row_rstd(const float* SS, int row, int stride, int fq, float inv_n) {
    const float* p = SS + (size_t)row * stride + fq * NPF; float s;
    if constexpr (NPF == 8) { const f32x4 a = *(const f32x4*)p, b = *(const f32x4*)(p + 4); s = ((a[0] + a[1]) + (a[2] + a[3])) + ((b[0] + b[1]) + (b[2] + b[3])); }
    else if constexpr (NPF == 6) { const f32x2e a = *(const f32x2e*)p, b = *(const f32x2e*)(p + 2), c = *(const f32x2e*)(p + 4); s = (a[0] + a[1]) + (b[0] + b[1]) + (c[0] + c[1]); }
    else { const f32x2e a = *(const f32x2e*)p; s = a[0] + a[1]; }
    s += __shfl_xor(s, 16); s += __shfl_xor(s, 32);
    return 1.0f / sqrtf(s * inv_n + NORM_EPS);
}
template <int NPF> __device__ __forceinline__ void rstd8(const float* SS, int row0, int stride, int fq, float inv_n, float (&rs)[8]) {
    f32x2e v[8][NPF / 2];
#pragma unroll
    for (int i = 0; i < 8; ++i) { const float* p = SS + (size_t)(row0 + (i >> 2) * HALF + (i & 3) * 16) * stride + fq * NPF;
#pragma unroll
        for (int k = 0; k < NPF / 2; ++k) v[i][k] = *(const f32x2e*)(p + 2 * k); }
#pragma unroll
    for (int i = 0; i < 8; ++i) { float s = 0.f;
#pragma unroll
        for (int k = 0; k < NPF / 2; ++k) s += v[i][k][0] + v[i][k][1];
        s += __shfl_xor(s, 16); s += __shfl_xor(s, 32);
        rs[i] = 1.0f / sqrtf(s * inv_n + NORM_EPS); }
}
__device__ __forceinline__ u32x4 pack8bf(const f32x4 v0, const f32x4 v1) { u32x4 w; w.x = cvt_pk_bf16(v0[0], v0[1]); w.y = cvt_pk_bf16(v0[2], v0[3]); w.z = cvt_pk_bf16(v1[0], v1[1]); w.w = cvt_pk_bf16(v1[2], v1[3]); return w; }
__device__ __forceinline__ u32x2 pack8f8(const f32x4 v0, const f32x4 v1) { unsigned lo = 0, hi = 0;
    lo = __builtin_amdgcn_cvt_pk_fp8_f32(v0[0], v0[1], lo, false); lo = __builtin_amdgcn_cvt_pk_fp8_f32(v0[2], v0[3], lo, true);
    hi = __builtin_amdgcn_cvt_pk_fp8_f32(v1[0], v1[1], hi, false); hi = __builtin_amdgcn_cvt_pk_fp8_f32(v1[2], v1[3], hi, true);
    return (u32x2){lo, hi}; }
typedef _Float16 h16x2 __attribute__((ext_vector_type(2)));
__device__ __forceinline__ unsigned pkh2(float lo, float hi) { const h16x2 p = {(_Float16)lo, (_Float16)hi}; return __builtin_bit_cast(unsigned, p); }
__device__ __forceinline__ u32x4 pack8h(const f32x4 v0, const f32x4 v1) { u32x4 w; w.x = pkh2(v0[0], v0[1]); w.y = pkh2(v0[2], v0[3]); w.z = pkh2(v1[0], v1[1]); w.w = pkh2(v1[2], v1[3]); return w; }
__device__ __forceinline__ float h_lo(unsigned w) { return (float)__builtin_bit_cast(h16x2, w)[0]; }
__device__ __forceinline__ float h_hi(unsigned w) { return (float)__builtin_bit_cast(h16x2, w)[1]; }
__device__ __forceinline__ float dot4(const f32x4 a) { return (a[0] * a[0] + a[1] * a[1]) + (a[2] * a[2] + a[3] * a[3]); }
__device__ __forceinline__ f32x4 silu_mul(const f32x4 g, const f32x4 u) { f32x4 o;
#pragma unroll
    for (int j = 0; j < 4; ++j) { const float e = __builtin_amdgcn_exp2f(g[j] * -1.4426950408889634f); o[j] = g[j] * __builtin_amdgcn_rcpf(1.0f + e) * u[j]; }
    return o; }
__device__ __forceinline__ f32x4 silu_mul_rs(const f32x4 g, const f32x4 u, const float k, const float rs2, const f32x4 one) {
    const f32x4 ea = g * k; f32x4 e;
#pragma unroll
    for (int j = 0; j < 4; ++j) e[j] = __builtin_amdgcn_exp2f(ea[j]);
    const f32x4 d = e + one; f32x4 r;
#pragma unroll
    for (int j = 0; j < 4; ++j) r[j] = __builtin_amdgcn_rcpf(d[j]);
    return (g * u) * (r * rs2); }

struct EpiSwiGLU {
    static constexpr bool PERM = true, AFTER_DRAIN = false, HAS_INIT = false;
    bf16_t* O; int ldc; const PG8_LAS float* rsl;
    __device__ __forceinline__ void operator()(const f32x4 (&acc)[2][2][4][2], const Unit& u, int wr, int wc, int fr, int fq) const {
        const int row0 = u.pm * BM + wr * 64 + fr, col0 = u.pn * HALF + wc * 32 + 8 * fq;
        const __amdgpu_buffer_rsrc_t rsrc = __builtin_amdgcn_make_buffer_rsrc(O, 0, 0x7fffffff, 0x00020000);
        float one1 = 1.0f; asm volatile("" : "+v"(one1)); const f32x4 one = {one1, one1, one1, one1};
#pragma unroll
        for (int ai = 0; ai < 2; ++ai)
#pragma unroll
            for (int m = 0; m < 4; ++m) { const int row = row0 + ai * HALF + m * 16; const float rs = rsl[ai * HALF + wr * 64 + m * 16 + fr];
                const float kk = rs * -1.4426950408889634f, rs2 = rs * rs;
                const f32x4 y0 = silu_mul_rs(acc[ai][0][m][0], acc[ai][1][m][0], kk, rs2, one), y1 = silu_mul_rs(acc[ai][0][m][1], acc[ai][1][m][1], kk, rs2, one);
                __builtin_amdgcn_raw_buffer_store_b128(pack8bf(y0, y1), rsrc, (int)(((unsigned)row * (unsigned)ldc + (unsigned)col0) * 2u), 0, 16);     }
    }
};
#ifndef RES_MODE
#define RES_MODE 0
#endif
template <bool W8, bool HALFSTEP> struct EpiResid {
    static constexpr bool PERM = true, AFTER_DRAIN = false, HAS_INIT = true;
    static constexpr float alpha = HALFSTEP ? 0.5f : 1.0f, inv_alpha = HALFSTEP ? 2.0f : 1.0f;
    bf16_t* hb; bf16_t* lo; float* SSo; unsigned char* hb8;
    __device__ __forceinline__ void init(f32x4 (&acc)[2][2][4][2], const Unit& u, int wr, int wc, int fr, int fq) const {
        const int row0 = u.pm * BM + wr * 64 + fr, col0 = u.pn * BM + wc * 32 + 8 * fq;
#pragma unroll
        for (int ai = 0; ai < 2; ++ai)
#pragma unroll
            for (int m = 0; m < 4; ++m)
#pragma unroll
                for (int bj = 0; bj < 2; ++bj) { const size_t off = (size_t)(row0 + ai * HALF + m * 16) * 2048 + col0 + bj * HALF; f32x4 x0, x1;
                    if constexpr (RES_MODE == 2) { const u32x4 a = *(const u32x4*)(lo + off); x0 = (f32x4){h_lo(a[0]), h_hi(a[0]), h_lo(a[1]), h_hi(a[1])}; x1 = (f32x4){h_lo(a[2]), h_hi(a[2]), h_lo(a[3]), h_hi(a[3])}; }
                    else { const u32x4 a = *(const u32x4*)(hb + off);
                        x0 = (f32x4){__uint_as_float(a[0] << 16), __uint_as_float(a[0] & 0xffff0000u), __uint_as_float(a[1] << 16), __uint_as_float(a[1] & 0xffff0000u)};
                        x1 = (f32x4){__uint_as_float(a[2] << 16), __uint_as_float(a[2] & 0xffff0000u), __uint_as_float(a[3] << 16), __uint_as_float(a[3] & 0xffff0000u)};
                        if constexpr (RES_MODE == 0) { const u32x4 b = *(const u32x4*)(lo + off);
                            x0 += (f32x4){__uint_as_float(b[0] << 16), __uint_as_float(b[0] & 0xffff0000u), __uint_as_float(b[1] << 16), __uint_as_float(b[1] & 0xffff0000u)};
                            x1 += (f32x4){__uint_as_float(b[2] << 16), __uint_as_float(b[2] & 0xffff0000u), __uint_as_float(b[3] << 16), __uint_as_float(b[3] & 0xffff0000u)}; } }
                    acc[ai][bj][m][0] = x0 * inv_alpha; acc[ai][bj][m][1] = x1 * inv_alpha; }
    }
    __device__ __forceinline__ void operator()(const f32x4 (&acc)[2][2][4][2], const Unit& u, int wr, int wc, int fr, int fq) const {
        const int row0 = u.pm * BM + wr * 64 + fr, col0 = u.pn * BM + wc * 32 + 8 * fq;
#pragma unroll
        for (int ai = 0; ai < 2; ++ai)
#pragma unroll
            for (int m = 0; m < 4; ++m) { const int row = row0 + ai * HALF + m * 16; float s = 0.f;
#pragma unroll
                for (int bj = 0; bj < 2; ++bj) { const size_t off = (size_t)row * 2048 + col0 + bj * HALF;
                    const f32x4 h0 = acc[ai][bj][m][0] * alpha, h1 = acc[ai][bj][m][1] * alpha;
                    const u32x4 w = pack8bf(h0, h1);
                    *(u32x4*)(hb + off) = w;
                    if constexpr (RES_MODE == 0) {
                        const f32x4 r0 = {h0[0] - __uint_as_float(w[0] << 16), h0[1] - __uint_as_float(w[0] & 0xffff0000u), h0[2] - __uint_as_float(w[1] << 16), h0[3] - __uint_as_float(w[1] & 0xffff0000u)};
                        const f32x4 r1 = {h1[0] - __uint_as_float(w[2] << 16), h1[1] - __uint_as_float(w[2] & 0xffff0000u), h1[2] - __uint_as_float(w[3] << 16), h1[3] - __uint_as_float(w[3] & 0xffff0000u)};
                        *(u32x4*)(lo + off) = pack8bf(r0, r1); }
                    if constexpr (RES_MODE == 2) *(u32x4*)(lo + off) = pack8h(h0, h1);
                    if constexpr (W8) *(u32x2*)(hb8 + off) = pack8f8(h0, h1);
                    s += dot4(h0) + dot4(h1); }
                s += __shfl_xor(s, 16); s += __shfl_xor(s, 32);
                if (fq == 0) SSo[(size_t)row * 32 + u.pn * 4 + wc] = s; }
    }
};
template <int MODE  > struct EpiQKVA {
    static constexpr bool PERM = true, AFTER_DRAIN = false, HAS_INIT = false;
    bf16_t* O; const PG8_LAS float* rsl; const float* cosT; const float* sinT; float wscale;
    __device__ __forceinline__ void operator()(const f32x4 (&acc)[2][2][4][2], const Unit& u, int wr, int wc, int fr, int fq) const {
        const int ot = (MODE == 0) ? u.pn : (MODE == 1 ? (u.pn >> 4) * 24 + (u.pn & 15) : (u.pn >> 3) * 24 + 16 + (u.pn & 7));
        const int row0 = u.pm * BM + wr * 64 + fr, col0 = ot * BM + wc * 32 + 8 * fq;
        const int t = (ot >> 3) % 3; const bool rope = (MODE != 2) && (t != 2) && (wc == 0);
        f32x4 cs[8], sn[8];
        if (rope) {
#pragma unroll
            for (int i = 0; i < 8; ++i) { const size_t ro = (size_t)(row0 + (i >> 2) * HALF + (i & 3) * 16) * 16 + 4 * fq; cs[i] = *(const f32x4*)(cosT + ro); sn[i] = *(const f32x4*)(sinT + ro); }
        } else {
#pragma unroll
            for (int i = 0; i < 8; ++i) { cs[i] = (f32x4){1.f, 1.f, 1.f, 1.f}; sn[i] = (f32x4){0.f, 0.f, 0.f, 0.f}; }
        }
        asm volatile("" ::: "memory");
#pragma unroll
        for (int ai = 0; ai < 2; ++ai)
#pragma unroll
            for (int m = 0; m < 4; ++m) { const int row = row0 + ai * HALF + m * 16; const float rs = rsl[ai * HALF + wr * 64 + m * 16 + fr] * wscale;
                const f32x4 c = cs[ai * 4 + m], s = sn[ai * 4 + m];
#pragma unroll
                for (int bj = 0; bj < 2; ++bj) { f32x4 v0 = acc[ai][bj][m][0] * rs, v1 = acc[ai][bj][m][1] * rs;
                    if (rope) { const f32x4 o0 = v0 * c - v1 * s, o1 = v1 * c + v0 * s; v0 = o0; v1 = o1; }
                    *(u32x4*)(O + (size_t)row * 18432 + col0 + bj * HALF) = pack8bf(v0, v1); } }
    }
};
struct EpiBin {
    static constexpr bool PERM = true, AFTER_DRAIN = false, HAS_INIT = false;
    bf16_t* CQ; bf16_t* CKV; bf16_t* KR; float* SSQ; float* SSKV; const float* SS; const float* cosT; const float* sinT;
    __device__ __forceinline__ void operator()(const f32x4 (&acc)[2][2][4][2], const Unit& u, int wr, int wc, int fr, int fq) const {
        const int row0 = u.pm * BM + wr * 64 + fr; const int pn = u.pn;
#pragma unroll
        for (int ai = 0; ai < 2; ++ai)
#pragma unroll
            for (int m = 0; m < 4; ++m) { const int row = row0 + ai * HALF + m * 16; const float rs = row_rstd<8>(SS, row, 32, fq, 1.0f / 2048.0f);
                if (pn < 8) {
                    bf16_t* dst; float* ssd;
                    if (pn < 6) { dst = CQ + (size_t)row * 1536 + pn * BM; ssd = SSQ + (size_t)row * 32 + pn * 4 + wc; }
                    else { dst = CKV + (size_t)row * 512 + (pn - 6) * BM; ssd = SSKV + (size_t)row * 8 + (pn - 6) * 4 + wc; }
                    float s = 0.f;
#pragma unroll
                    for (int bj = 0; bj < 2; ++bj) { const f32x4 v0 = acc[ai][bj][m][0] * rs, v1 = acc[ai][bj][m][1] * rs; s += dot4(v0) + dot4(v1);
                        *(u32x4*)(dst + bj * HALF + wc * 32 + 8 * fq) = pack8bf(v0, v1); }
                    s += __shfl_xor(s, 16); s += __shfl_xor(s, 32);
                    if (fq == 0) *ssd = s;
                } else if (wc == 0) {
                    const f32x4 x1a = acc[ai][0][m][0] * rs, x1b = acc[ai][0][m][1] * rs, x2a = acc[ai][1][m][0] * rs, x2b = acc[ai][1][m][1] * rs;
                    const float* cp = cosT + (size_t)row * 32 + 8 * fq; const float* sp = sinT + (size_t)row * 32 + 8 * fq;
                    const f32x4 c0 = *(const f32x4*)cp, c1 = *(const f32x4*)(cp + 4), s0 = *(const f32x4*)sp, s1 = *(const f32x4*)(sp + 4);
                    *(u32x4*)(KR + (size_t)row * 64 + 8 * fq) = pack8bf(x1a * c0 - x2a * s0, x1b * c1 - x2b * s1);
                    *(u32x4*)(KR + (size_t)row * 64 + 32 + 8 * fq) = pack8bf(x2a * c0 + x1a * s0, x2b * c1 + x1b * s1);
                } asm volatile("" ::: "memory"); }
    }
};
struct EpiUQ {
    static constexpr bool PERM = true, AFTER_DRAIN = false, HAS_INIT = false;
    bf16_t* QN; bf16_t* QRo; const PG8_LAS float* rsl; const float* cosT; const float* sinT;
    __device__ __forceinline__ void operator()(const f32x4 (&acc)[2][2][4][2], const Unit& u, int wr, int wc, int fr, int fq) const {
        const int row0 = u.pm * BM + wr * 64 + fr; const int pn = u.pn;
#pragma unroll
        for (int ai = 0; ai < 2; ++ai)
#pragma unroll
            for (int m = 0; m < 4; ++m) { const int row = row0 + ai * HALF + m * 16; const float rs = rsl[ai * HALF + wr * 64 + m * 16 + fr];
                if (pn < 8) {
#pragma unroll
                    for (int bj = 0; bj < 2; ++bj) *(u32x4*)(QN + (size_t)row * 2048 + pn * BM + bj * HALF + wc * 32 + 8 * fq) = pack8bf(acc[ai][bj][m][0] * rs, acc[ai][bj][m][1] * rs);
                } else {
                    const int head = (pn - 8) * 4 + wc;
                    const f32x4 x1a = acc[ai][0][m][0] * rs, x1b = acc[ai][0][m][1] * rs, x2a = acc[ai][1][m][0] * rs, x2b = acc[ai][1][m][1] * rs;
                    const float* cp = cosT + (size_t)row * 32 + 8 * fq; const float* sp = sinT + (size_t)row * 32 + 8 * fq;
                    const f32x4 c0 = *(const f32x4*)cp, c1 = *(const f32x4*)(cp + 4), s0 = *(const f32x4*)sp, s1 = *(const f32x4*)(sp + 4);
                    bf16_t* d = QRo + (size_t)row * 1024 + head * 64 + 8 * fq;
                    *(u32x4*)d = pack8bf(x1a * c0 - x2a * s0, x1b * c1 - x2b * s1);
                    *(u32x4*)(d + 32) = pack8bf(x2a * c0 + x1a * s0, x2b * c1 + x1b * s1);
                } asm volatile("" ::: "memory"); }
    }
};
struct EpiUKV {
    static constexpr bool PERM = true, AFTER_DRAIN = false, HAS_INIT = false;
    bf16_t* KN; bf16_t* VB; const PG8_LAS float* rsl;
    __device__ __forceinline__ void operator()(const f32x4 (&acc)[2][2][4][2], const Unit& u, int wr, int wc, int fr, int fq) const {
        const int row0 = u.pm * BM + wr * 64 + fr; const int col0 = u.pn * HALF + wc * 32 + 8 * fq;
#pragma unroll
        for (int ai = 0; ai < 2; ++ai)
#pragma unroll
            for (int m = 0; m < 4; ++m) { const int row = row0 + ai * HALF + m * 16; const float rs = rsl[ai * HALF + wr * 64 + m * 16 + fr];
                *(u32x4*)(KN + (size_t)row * 2048 + col0) = pack8bf(acc[ai][0][m][0] * rs, acc[ai][0][m][1] * rs);
                *(u32x4*)(VB + (size_t)row * 2048 + col0) = pack8bf(acc[ai][1][m][0] * rs, acc[ai][1][m][1] * rs); asm volatile("" ::: "memory"); }
    }
};
struct EpiCin {
    static constexpr bool PERM = true, AFTER_DRAIN = false, HAS_INIT = false;
    bf16_t* CU; bf16_t* BG; const PG8_LAS float* rsl;
    __device__ __forceinline__ void operator()(const f32x4 (&acc)[2][2][4][2], const Unit& u, int wr, int wc, int fr, int fq) const {
        const int row0 = u.pm * BM + wr * 64 + fr; const int pn = u.pn;
#pragma unroll
        for (int ai = 0; ai < 2; ++ai)
#pragma unroll
            for (int m = 0; m < 4; ++m) { const int row = row0 + ai * HALF + m * 16; const float rs = rsl[ai * HALF + wr * 64 + m * 16 + fr];
                if (pn < 16) { const float r2 = rs * rs;
                    *(u32x4*)(CU + (size_t)row * 2048 + pn * HALF + wc * 32 + 8 * fq) = pack8bf(acc[ai][0][m][0] * acc[ai][1][m][0] * r2, acc[ai][0][m][1] * acc[ai][1][m][1] * r2);
                } else {
#pragma unroll
                    for (int bj = 0; bj < 2; ++bj) *(u32x4*)(BG + (size_t)row * 2048 + (pn - 16) * BM + bj * HALF + wc * 32 + 8 * fq) = pack8bf(acc[ai][bj][m][0] * rs, acc[ai][bj][m][1] * rs);
                } asm volatile("" ::: "memory"); }
    }
};
typedef int i32x8 __attribute__((ext_vector_type(8)));
typedef _Float16 h16x8 __attribute__((ext_vector_type(8)));
template <class Epi, class Sched, bool ALIGN_EPI = false, bool SP2 = false, bool F8 = false, bool HF = false  >
__device__ __forceinline__ void gemm_phase(PG8_LAS unsigned char* lds, const Gemm g, const Sched& S, const Epi& E, const int wave_in) {
    int tid_ = wave_in * 64 + hw_lane(); asm volatile("" : "+v"(tid_));
    const int tid = tid_, wid = __builtin_amdgcn_readfirstlane(tid >> 6), lane = tid & 63, wr = wid >> 2, wc = wid & 3, fr = lane & 15, fq = lane >> 4;
    const int K = g.K, nt = K / BK;
    unsigned voffA[2], voffB[2];
#pragma unroll
    for (int i = 0; i < 2; ++i) { int R, C; stage_rc(tid * 16 + i * 8192, R, C); const int Rb = Epi::PERM ? ((R & ~31) + perm32(R & 31)) : R;
        voffA[i] = (unsigned)(R * K + C) * 2u; voffB[i] = (unsigned)(Rb * K + C) * 2u; }
    const size_t kstep = (size_t)(BK * 2);
    const size_t hstep = (size_t)HALF * K * 2;
    const size_t tstep = 2 * hstep;
    const unsigned ldsw = (unsigned)wid * 1024u;
    const int aoff = lds_byte(wr * 64 + fr, fq * 8), boff = lds_byte(wc * 32 + fr, fq * 8);
#define PG8_SA(b, h) (((b) * 2 + (h)) * HTB)
#define PG8_SB(b, h) ((4 + (b) * 2 + (h)) * HTB)
#define PG8_STAGE(bufoff, gbase, voff) do { _Pragma("unroll") for (int _i = 0; _i < 2; ++_i) \
        __builtin_amdgcn_global_load_lds((const unsigned*)((const char*)(gbase) + (voff)[_i]), (PG8_LAS unsigned*)(lds + (bufoff) + ldsw + _i * 8192), 16, 0, 0); } while (0)
#define PG8_LD1(off_) (*(const PG8_LAS i32x4*)(lds + (off_)))
#define PG8_LDA(dst, b, h) do { if constexpr (F8) { _Pragma("unroll") for (int m = 0; m < 4; ++m) dst##8[m] = __builtin_shufflevector(PG8_LD1(PG8_SA(b, h) + aoff + m * 2048), PG8_LD1(PG8_SA(b, h) + aoff + m * 2048 + 1024), 0, 1, 2, 3, 4, 5, 6, 7); } \
        else { _Pragma("unroll") for (int m = 0; m < 4; ++m) _Pragma("unroll") for (int k = 0; k < 2; ++k) dst[m][k] = *(const PG8_LAS bf16x8*)(lds + PG8_SA(b, h) + aoff + m * 2048 + k * 1024); } } while (0)
#define PG8_LDB(dst, b, h) do { if constexpr (F8) { _Pragma("unroll") for (int n = 0; n < 2; ++n) dst##8[n] = __builtin_shufflevector(PG8_LD1(PG8_SB(b, h) + boff + n * 2048), PG8_LD1(PG8_SB(b, h) + boff + n * 2048 + 1024), 0, 1, 2, 3, 4, 5, 6, 7); } \
        else { _Pragma("unroll") for (int n = 0; n < 2; ++n) _Pragma("unroll") for (int k = 0; k < 2; ++k) dst[n][k] = *(const PG8_LAS bf16x8*)(lds + PG8_SB(b, h) + boff + n * 2048 + k * 1024); } } while (0)
#define PG8_MMA(ai, bj, At, Bt) do { __builtin_amdgcn_s_setprio(1); \
        if constexpr (F8) { _Pragma("unroll") for (int m = 0; m < 4; ++m) _Pragma("unroll") for (int n = 0; n < 2; ++n) \
            asm volatile("v_mfma_scale_f32_16x16x128_f8f6f4 %0, %1, %2, %0, %3, %3 op_sel_hi:[0,0,0]" : "+v"(acc[ai][bj][m][n]) : "v"(Bt##8[n]), "v"(At##8[m]), "v"(sc7f)); } \
        else { _Pragma("unroll") for (int m = 0; m < 4; ++m) _Pragma("unroll") for (int n = 0; n < 2; ++n) _Pragma("unroll") for (int k = 0; k < 2; ++k) \
        acc[ai][bj][m][n] = HF ? __builtin_amdgcn_mfma_f32_16x16x32_f16(__builtin_bit_cast(h16x8, Bt[n][k]), __builtin_bit_cast(h16x8, At[m][k]), acc[ai][bj][m][n], 0, 0, 0) \
                                : __builtin_amdgcn_mfma_f32_16x16x32_bf16(Bt[n][k], At[m][k], acc[ai][bj][m][n], 0, 0, 0); } __builtin_amdgcn_s_setprio(0); } while (0)
#define PG8_WAIT_V(n) asm volatile("s_waitcnt vmcnt(" #n ")" ::: "memory")
#define PG8_WAIT_L(n) asm volatile("s_waitcnt lgkmcnt(" #n ")" ::: "memory")
#define PG8_BAR __builtin_amdgcn_s_barrier()
#define PG8_WAIT_V8_UNLESS(f) asm volatile("s_cmp_lg_u32 %0, 0\n\ts_cbranch_scc1 .Lpg8sk%=\n\ts_waitcnt vmcnt(8)\n.Lpg8sk%=:" :: "s"(f) : "scc", "memory")
#define PG8_SCHED __builtin_amdgcn_sched_barrier(0)
#ifndef SKIPW_ON
#define SKIPW_ON 0
#endif
    constexpr bool SKIPW = SKIPW_ON && !Epi::HAS_INIT;
    Unit cur, nxt; int ui = 0;
    if (!S.next(0, cur)) return;
    f32x4 acc[2][2][4][2];
    if constexpr (Epi::HAS_INIT) { E.init(acc, cur, wr, wc, fr, fq); } else {
#pragma unroll
    for (int a = 0; a < 2; ++a)
#pragma unroll
        for (int b = 0; b < 2; ++b)
#pragma unroll
            for (int m = 0; m < 4; ++m)
#pragma unroll
                for (int n = 0; n < 2; ++n) acc[a][b][m][n] = (f32x4){0.f, 0.f, 0.f, 0.f};
    }
    const int sc7f = 0x7F7F7F7F; (void)sc7f;
    bf16x8 At[4][2], B0[2][2], B1[2][2]; i32x8 At8[4], B08[2], B18[2]; (void)At; (void)B0; (void)B1; (void)At8; (void)B08; (void)B18;
    const char* cA = (const char*)g.A + (size_t)cur.pm * tstep; const char* cB = (const char*)g.Bt + (size_t)cur.pn * tstep;
    S.a_ready(cur);
    if constexpr (SP2) {
        PG8_STAGE(PG8_SB(0, 0), cB, voffB); PG8_STAGE(PG8_SB(0, 1), cB + hstep, voffB); PG8_STAGE(PG8_SA(0, 0), cA, voffA); PG8_STAGE(PG8_SA(0, 1), cA + hstep, voffA);
        if (wr == 1) PG8_BAR;
        PG8_WAIT_V(2); PG8_BAR;
        PG8_STAGE(PG8_SB(1, 0), cB + kstep, voffB); PG8_STAGE(PG8_SA(1, 0), cA + kstep, voffA); PG8_STAGE(PG8_SB(1, 1), cB + hstep + kstep, voffB);
        PG8_WAIT_V(6); PG8_BAR;
    } else {
        PG8_STAGE(PG8_SB(0, 0), cB, voffB); PG8_STAGE(PG8_SA(0, 0), cA, voffA); PG8_STAGE(PG8_SB(0, 1), cB + hstep, voffB); PG8_STAGE(PG8_SA(0, 1), cA + hstep, voffA);
        if (wr == 1) PG8_BAR;
        PG8_WAIT_V(4); PG8_BAR;
        PG8_STAGE(PG8_SB(1, 0), cB + kstep, voffB); PG8_STAGE(PG8_SA(1, 0), cA + kstep, voffA); PG8_STAGE(PG8_SB(1, 1), cB + hstep + kstep, voffB);
        PG8_WAIT_V(6); PG8_BAR;
    }
    for (;;) {
        const bool has_next = S.next(ui + 1, nxt);
        const char* nA = has_next ? (const char*)g.A + (size_t)nxt.pm * tstep : cA; const char* nB = has_next ? (const char*)g.Bt + (size_t)nxt.pn * tstep : cB;
        for (int t = 0; t < nt; t += 2) {
            const bool last = (t == nt - 2);
            const char* a1 = cA + (size_t)(t + 1) * kstep;
            const char* a2 = last ? nA : cA + (size_t)(t + 2) * kstep; const char* b2 = last ? nB : cB + (size_t)(t + 2) * kstep;
            const char* a3 = a2 + kstep; const char* b3 = b2 + kstep;
            if (last && has_next) S.a_ready(nxt);
            const int skipw_ = __builtin_amdgcn_readfirstlane((t == 0 && ui > 0) ? 1 : 0); (void)skipw_;
            if constexpr (SP2) {
            PG8_LDB(B0, 0, 0); PG8_LDB(B1, 0, 1); PG8_SCHED; PG8_LDA(At, 0, 0); PG8_STAGE(PG8_SA(1, 1), a1 + hstep, voffA);
            if constexpr (SKIPW) PG8_WAIT_V8_UNLESS(skipw_); else PG8_WAIT_V(8); PG8_WAIT_L(0); PG8_BAR; PG8_MMA(0, 0, At, B0); PG8_MMA(0, 1, At, B1); PG8_BAR; PG8_SCHED;
            PG8_LDA(At, 0, 1); PG8_STAGE(PG8_SB(0, 0), b2, voffB); PG8_STAGE(PG8_SB(0, 1), b2 + hstep, voffB); PG8_STAGE(PG8_SA(0, 0), a2, voffA);
            if constexpr (SKIPW) PG8_WAIT_V8_UNLESS(skipw_); else PG8_WAIT_V(8); PG8_WAIT_L(0); PG8_BAR; PG8_MMA(1, 0, At, B0); PG8_MMA(1, 1, At, B1); PG8_BAR; PG8_SCHED;
            PG8_LDB(B0, 1, 0); PG8_LDB(B1, 1, 1); PG8_SCHED; PG8_LDA(At, 1, 0); PG8_STAGE(PG8_SA(0, 1), a2 + hstep, voffA);
            PG8_WAIT_V(8); PG8_WAIT_L(0); PG8_BAR; PG8_MMA(0, 0, At, B0); PG8_MMA(0, 1, At, B1); PG8_BAR; PG8_SCHED;
            PG8_LDA(At, 1, 1); PG8_STAGE(PG8_SB(1, 0), b3, voffB); PG8_STAGE(PG8_SB(1, 1), b3 + hstep, voffB); PG8_STAGE(PG8_SA(1, 0), a3, voffA);
            PG8_WAIT_V(8); PG8_WAIT_L(0); PG8_BAR; PG8_MMA(1, 0, At, B0); PG8_MMA(1, 1, At, B1); PG8_BAR; PG8_SCHED;
            } else {
            PG8_LDB(B0, 0, 0); PG8_SCHED; PG8_LDA(At, 0, 0); PG8_STAGE(PG8_SA(1, 1), a1 + hstep, voffA);
            PG8_WAIT_L(8); PG8_BAR; PG8_WAIT_L(0); PG8_MMA(0, 0, At, B0); PG8_BAR; PG8_SCHED;
            PG8_LDB(B1, 0, 1); PG8_STAGE(PG8_SB(0, 0), b2, voffB);
            PG8_BAR; PG8_WAIT_L(0); PG8_MMA(0, 1, At, B1); PG8_BAR;
            PG8_LDA(At, 0, 1); PG8_STAGE(PG8_SA(0, 0), a2, voffA);
            PG8_BAR; PG8_WAIT_L(0); PG8_MMA(1, 0, At, B0); PG8_BAR; PG8_SCHED;
            PG8_STAGE(PG8_SB(0, 1), b2 + hstep, voffB);
            PG8_WAIT_V(6); PG8_BAR; PG8_MMA(1, 1, At, B1); PG8_BAR;
            PG8_LDB(B0, 1, 0); PG8_SCHED; PG8_LDA(At, 1, 0); PG8_STAGE(PG8_SA(0, 1), a2 + hstep, voffA);
            PG8_WAIT_L(8); PG8_BAR; PG8_WAIT_L(0); PG8_MMA(0, 0, At, B0); PG8_BAR; PG8_SCHED;
            PG8_LDB(B1, 1, 1); PG8_STAGE(PG8_SB(1, 0), b3, voffB);
            PG8_BAR; PG8_WAIT_L(0); PG8_MMA(0, 1, At, B1); PG8_BAR;
            PG8_LDA(At, 1, 1); PG8_STAGE(PG8_SA(1, 0), a3, voffA);
            PG8_BAR; PG8_WAIT_L(0); PG8_MMA(1, 0, At, B0); PG8_BAR; PG8_SCHED;
            PG8_STAGE(PG8_SB(1, 1), b3 + hstep, voffB);
            PG8_WAIT_V(6); PG8_BAR; PG8_MMA(1, 1, At, B1); PG8_BAR;
            }
        }
        if constexpr (ALIGN_EPI) { if (wr == 0) PG8_BAR; }
        if constexpr (F8) asm volatile("s_nop 15\n\ts_nop 15" ::: "memory");
        if constexpr (SKIPW) { if (has_next) PG8_WAIT_V(0); }
        if constexpr (!Epi::AFTER_DRAIN) { const int le_ = hw_lane(); E(acc, cur, wr, wc, le_ & 15, le_ >> 4); S.done(cur); }
        if (!has_next) break;
        if constexpr (Epi::HAS_INIT) { const int li_ = hw_lane(); E.init(acc, nxt, wr, wc, li_ & 15, li_ >> 4); } else {
#pragma unroll
        for (int a = 0; a < 2; ++a)
#pragma unroll
            for (int b = 0; b < 2; ++b)
#pragma unroll
                for (int m = 0; m < 4; ++m)
#pragma unroll
                    for (int n = 0; n < 2; ++n) acc[a][b][m][n] = (f32x4){0.f, 0.f, 0.f, 0.f};
        }
        cur = nxt; cA = nA; cB = nB; ++ui;
        if constexpr (ALIGN_EPI) { if (wr == 1) PG8_BAR; }
    }
    PG8_WAIT_V(0);
    if constexpr (!ALIGN_EPI) { if (wr == 0) PG8_BAR; }
    PG8_BAR;
    if constexpr (Epi::AFTER_DRAIN) { E.fused(acc, cur, wr, wc, fr, fq, lds, wid, lane); S.done(cur); }
#undef PG8_SA
#undef PG8_SB
#undef PG8_STAGE
#undef PG8_LDA
#undef PG8_LD1
#undef PG8_LDB
#undef PG8_MMA
#undef PG8_WAIT_V
#undef PG8_WAIT_L
#undef PG8_BAR
#undef PG8_SCHED
}
}
namespace att {
typedef unsigned short bf16;
typedef short bf16x8 __attribute__((ext_vector_type(8)));
typedef short s16x4 __attribute__((ext_vector_type(4)));
typedef float f32x16 __attribute__((ext_vector_type(16)));
typedef float f32x4 __attribute__((ext_vector_type(4)));
typedef unsigned u32x4 __attribute__((ext_vector_type(4)));
constexpr int NW = 8, QBLK = 32, KVBLK = 64, QB = NW * QBLK;
constexpr int SHM_V = KVBLK * 128 * 2;
constexpr float THR = 8.f;
struct CfgA { static constexpr bool EXT = false, SK = true, LSEOUT = true; static constexpr float SCALE = 0.08838834764831845f; };
struct CfgB { static constexpr bool EXT = true, SK = false, LSEOUT = false; static constexpr float SCALE = 0.07216878364870322f; };
template <class C> struct Geo { static constexpr int KROW = C::EXT ? 384 : 256, SHM_K = KVBLK * KROW;
    static constexpr int OFF_K = 2 * SHM_V, OFF_WS = OFF_K + 2 * SHM_K, OFF_QR = OFF_WS + NW * 64 * 4, LDS_BYTES = OFF_QR + (C::EXT ? NW * 4096 : 0); };
#define SBAR() __builtin_amdgcn_sched_barrier(0)
__device__ __forceinline__ int v_st(int k, int c) { const int kk = (k & ~0xC) | ((k & 4) << 1) | ((k & 8) >> 1); return ((kk >> 3) * 4 + (c >> 5)) * 512 + ((kk & 7) * 32 + (c & 31)) * 2; }
__device__ __forceinline__ int v_rd_base(int lane) { return ((lane & 3) << 3) | (((lane >> 2) & 3) << 6) | (((lane >> 4) & 1) << 5) | (((lane >> 5) & 1) << 8); }
constexpr int v_rd_off(int d0, int ks, int half) { return d0 * 512 + ks * 4096 + half * 2048; }
__device__ __forceinline__ int crow(int r, int hi) { return (r & 3) + 8 * (r >> 2) + 4 * hi; }
__device__ __forceinline__ unsigned cvtpk(float lo, float hi) { unsigned r; asm volatile("v_cvt_pk_bf16_f32 %0, %1, %2" : "=v"(r) : "v"(lo), "v"(hi)); return r; }
__device__ __forceinline__ bf16x8 load8(const bf16* p) { return *reinterpret_cast<const bf16x8*>(p); }
__device__ __forceinline__ void mask_tile(f32x16& p0, f32x16& p1, int dq, unsigned W) {
    const float NEG = -__builtin_inff();
#pragma unroll
    for (int r = 0; r < 16; ++r) {
        const int c = (r & 3) + 8 * (r >> 2);
        if ((unsigned)(dq - c) >= W) p0[r] = NEG;
        if ((unsigned)(dq - c - 32) >= W) p1[r] = NEG;
    }
}
template <class C>
__device__ __forceinline__ void partialSM(f32x16& p0, f32x16& p1, float& m_reg, float& mn, float& alpha) {
    constexpr float SCALE = C::SCALE;
    float pmax = p0[0];
#pragma unroll
    for (int r = 1; r < 16; ++r) pmax = fmaxf(pmax, p0[r]);
#pragma unroll
    for (int r = 0; r < 16; ++r) pmax = fmaxf(pmax, p1[r]);
    { auto rr = __builtin_amdgcn_permlane32_swap(__float_as_uint(pmax), __float_as_uint(pmax), false, false);
      pmax = fmaxf(__uint_as_float(rr[0]), __uint_as_float(rr[1])); }
    constexpr float C2 = 1.4426950408889634f * SCALE;
    if (__builtin_expect(__all((pmax - m_reg) * SCALE <= THR), 1)) { mn = m_reg; alpha = 1.f; }
    else { mn = fmaxf(m_reg, pmax); alpha = __builtin_amdgcn_exp2f((m_reg - mn) * C2); m_reg = mn; }
    const float mnL = -mn * C2;
#pragma unroll
    for (int r = 0; r < 16; ++r) p0[r] = fmaf(p0[r], C2, mnL);
#pragma unroll
    for (int r = 0; r < 16; ++r) p1[r] = fmaf(p1[r], C2, mnL);
#pragma unroll
    for (int r = 0; r < 16; ++r) p0[r] = __builtin_amdgcn_exp2f(p0[r]);
}
__device__ __forceinline__ void finishSM(f32x16& p0, f32x16& p1, float alpha, float& l_reg, bf16x8& pa0, bf16x8& pa1, bf16x8& pa2, bf16x8& pa3) {
#pragma unroll
    for (int r = 0; r < 16; ++r) p1[r] = __builtin_amdgcn_exp2f(p1[r]);
    float ps = 0;
#pragma unroll
    for (int r = 0; r < 16; ++r) ps += p0[r];
#pragma unroll
    for (int r = 0; r < 16; ++r) ps += p1[r];
    { auto rr = __builtin_amdgcn_permlane32_swap(__float_as_uint(ps), __float_as_uint(ps), false, false);
      ps = __uint_as_float(rr[0]) + __uint_as_float(rr[1]); }
    l_reg = l_reg * alpha + ps;
#define PK4(P, B_, OUT) do { unsigned a0 = cvtpk(P[B_+0], P[B_+1]), a1 = cvtpk(P[B_+2], P[B_+3]);                          \
        unsigned b0 = cvtpk(P[B_+4], P[B_+5]), b1 = cvtpk(P[B_+6], P[B_+7]);                                             \
        auto r0 = __builtin_amdgcn_permlane32_swap(a0, b0, false, false); auto r1 = __builtin_amdgcn_permlane32_swap(a1, b1, false, false); \
        u32x4 w = {r0[0], r1[0], r0[1], r1[1]}; OUT = *reinterpret_cast<bf16x8*>(&w); } while (0)
    PK4(p0, 0, pa0); PK4(p0, 8, pa1); PK4(p1, 0, pa2); PK4(p1, 8, pa3);
#undef PK4
}
#define KSWZ(row, colB) ((row) * KROW + ((colB) ^ (((row) & 7) << 4)))
template <class C, int KB>
__device__ __forceinline__ void qkt(f32x16& p0, f32x16& p1, const char* K_lds, const char* QR_w, int lane, int r32, int hi, const bf16x8* qr, bool act) {
    constexpr int KROW = Geo<C>::KROW, SHM_K = Geo<C>::SHM_K;
    if (C::SK && !act) { const float NEG = -__builtin_inff();
#pragma unroll
        for (int r = 0; r < 16; ++r) { p0[r] = NEG; p1[r] = NEG; } return; }
    p0 = f32x16{}; p1 = f32x16{};
    const char* kb[4];
#pragma unroll
    for (int dd = 0; dd < 4; ++dd) kb[dd] = K_lds + KB * SHM_K + KSWZ(r32, (dd * 16 + hi * 8) * 2);
#pragma unroll
    for (int d0 = 0; d0 < 8; ++d0) { const char* a = kb[d0 & 3] + (d0 >> 2) * 128;
        bf16x8 b0 = *reinterpret_cast<const bf16x8*>(a);
        bf16x8 b1 = *reinterpret_cast<const bf16x8*>(a + 32 * KROW);
        p0 = __builtin_amdgcn_mfma_f32_32x32x16_bf16(b0, qr[d0], p0, 0, 0, 0);
        p1 = __builtin_amdgcn_mfma_f32_32x32x16_bf16(b1, qr[d0], p1, 0, 0, 0); }
    if constexpr (C::EXT) {
#pragma unroll
        for (int d0 = 0; d0 < 4; ++d0) { const char* a = kb[d0] + 256;
            bf16x8 b0 = *reinterpret_cast<const bf16x8*>(a);
            bf16x8 b1 = *reinterpret_cast<const bf16x8*>(a + 32 * KROW);
            bf16x8 qf = *reinterpret_cast<const bf16x8*>(QR_w + (d0 * 64 + lane) * 16);
            p0 = __builtin_amdgcn_mfma_f32_32x32x16_bf16(b0, qf, p0, 0, 0, 0);
            p1 = __builtin_amdgcn_mfma_f32_32x32x16_bf16(b1, qf, p1, 0, 0, 0); }
    }
}
template <class C, int VB>
__device__ __forceinline__ void pv_tile(f32x16* o, int vb0, bf16x8 pa0, bf16x8 pa1, bf16x8 pa2, bf16x8 pa3, bool act) {
    if (C::SK && !act) return;
#define TRRD(dst, off) asm volatile("ds_read_b64_tr_b16 %0, %1 offset:%2" : "=&v"(dst) : "v"(vb0), "i"(off) : "memory")
#define PV_D0(d0) do { s16x4 l0, l1, l2, l3, h0, h1, h2, h3; constexpr int b_ = VB * SHM_V + v_rd_off(d0, 0, 0); \
        TRRD(l0, b_); TRRD(h0, b_ + 2048); TRRD(l1, b_ + 4096); TRRD(h1, b_ + 6144); TRRD(l2, b_ + 8192); TRRD(h2, b_ + 10240); TRRD(l3, b_ + 12288); TRRD(h3, b_ + 14336); \
        asm volatile("s_waitcnt lgkmcnt(0)" ::: "memory"); SBAR();   \
        o[d0] = __builtin_amdgcn_mfma_f32_32x32x16_bf16(pa0, (bf16x8){l0[0], l0[1], l0[2], l0[3], h0[0], h0[1], h0[2], h0[3]}, o[d0], 0, 0, 0);   \
        o[d0] = __builtin_amdgcn_mfma_f32_32x32x16_bf16(pa1, (bf16x8){l1[0], l1[1], l1[2], l1[3], h1[0], h1[1], h1[2], h1[3]}, o[d0], 0, 0, 0);   \
        o[d0] = __builtin_amdgcn_mfma_f32_32x32x16_bf16(pa2, (bf16x8){l2[0], l2[1], l2[2], l2[3], h2[0], h2[1], h2[2], h2[3]}, o[d0], 0, 0, 0);   \
        o[d0] = __builtin_amdgcn_mfma_f32_32x32x16_bf16(pa3, (bf16x8){l3[0], l3[1], l3[2], l3[3], h3[0], h3[1], h3[2], h3[3]}, o[d0], 0, 0, 0); } while (0)
    PV_D0(0); PV_D0(1); PV_D0(2); PV_D0(3);
#undef PV_D0
#undef TRRD
}
struct Tens { bf16* QN; bf16* QR; bf16* KN; bf16* KR; bf16* VB; bf16* OC; };
struct Blk { bf16* base; float* lse; int P0, ld, ldl, row0, hd; };
template <class C> __device__ __forceinline__ const bf16* q_row0(const Blk& b, const Tens& T) { if constexpr (C::EXT) return T.QN + (size_t)(b.row0 + b.P0) * 2048 + b.hd * 128; else return b.base + (size_t)b.P0 * b.ld; }
template <class C> __device__ __forceinline__ bf16* o_row0(const Blk& b, const Tens& T) { if constexpr (C::EXT) return T.OC + (size_t)(b.row0 + b.P0) * 2048 + b.hd * 128; else return b.base + (size_t)b.P0 * b.ld; }
template <class C> __device__ __forceinline__ const bf16* k_row0(const Blk& b, const Tens& T) { if constexpr (C::EXT) return T.KN + (size_t)b.row0 * 2048 + b.hd * 128; else return b.base + 2048; }
template <class C> __device__ __forceinline__ const bf16* v_row0(const Blk& b, const Tens& T) { if constexpr (C::EXT) return T.VB + (size_t)b.row0 * 2048 + b.hd * 128; else return b.base + 4096; }
template <class C> __device__ __forceinline__ int ld_of(const Blk& b) { if constexpr (C::EXT) return 2048; else return b.ld; }
__device__ __forceinline__ int swa_jlo(int P0, int W) { const int lowk = P0 - W + 1; return lowk > 0 ? lowk / KVBLK : 0; }
#define VMW() asm volatile("s_waitcnt vmcnt(0)" ::: "memory")
template <class C>
__device__ __forceinline__ void attn_block(const Blk& cur, const Tens& T, int skv, int W, char* lds, const int wave_in) {
    constexpr int KROW = Geo<C>::KROW, SHM_K = Geo<C>::SHM_K; constexpr bool SK = C::SK; constexpr float SCALE = C::SCALE;
    int tid_ = wave_in * 64 + hw_lane(); asm volatile("" : "+v"(tid_));
    const int tid = tid_, wid = __builtin_amdgcn_readfirstlane(tid >> 6), lane = tid & 63, r32 = lane & 31, hi = lane >> 5;
    const int j_lo = swa_jlo(cur.P0, W);
    int j_hi = (cur.P0 + QB - 1) / KVBLK + 1; if (j_hi > skv / KVBLK) j_hi = skv / KVBLK;
    const int NT = j_hi - j_lo;
    const int qlo = cur.P0 + wid * QBLK, qm = qlo + r32 - 4 * hi;
    char* V_lds = lds; char* K_lds = lds + Geo<C>::OFF_K;
    float* ws = (float*)(lds + Geo<C>::OFF_WS) + wid * 64; float* li_l = ws, * al_l = ws + 32;
    char* QR_w = lds + Geo<C>::OFF_QR + wid * 4096;
    const int sr = tid >> 4, sc = (tid & 15) * 8, vst0 = v_st(sr, sc), vst1 = v_st(32 + sr, sc), kws = KSWZ(sr, sc * 2);
    const int rr8 = tid >> 3, rc8 = (tid & 7) * 8, kwr = KSWZ(rr8, 256 + rc8 * 2);
    (void)kwr; (void)rr8; (void)rc8; (void)QR_w;
    const int vb0 = (int)(uintptr_t)V_lds + v_rd_base(lane);
    const bf16* kp = k_row0<C>(cur, T); const bf16* vp = v_row0<C>(cur, T); const int ld = ld_of<C>(cur);
    bf16x8 s0_v0, s0_v1, s0_k0, s0_k1, s0_kr, s1_v0, s1_v1, s1_k0, s1_k1, s1_kr;
    constexpr int NLD = C::EXT ? 5 : 4;
#define KBASE(t) ((j_lo + (t)) * KVBLK)
#define ACT(t) (KBASE(t) <= qlo + QBLK - 1 && KBASE(t) + KVBLK - 1 >= qlo - W + 1)
#define SLOAD(S_, k0) do { S_##_v0 = load8(vp + (size_t)((k0) + sr) * ld + sc); S_##_v1 = load8(vp + (size_t)((k0) + 32 + sr) * ld + sc); \
                       S_##_k0 = load8(kp + (size_t)((k0) + sr) * ld + sc); S_##_k1 = load8(kp + (size_t)((k0) + 32 + sr) * ld + sc); \
                       if constexpr (C::EXT) S_##_kr = load8(T.KR + (size_t)(cur.row0 + (k0) + rr8) * 64 + rc8); } while (0)
#define SWRITE(S_, bf) do { *(bf16x8*)(V_lds + (bf) * SHM_V + vst0) = S_##_v0; *(bf16x8*)(V_lds + (bf) * SHM_V + vst1) = S_##_v1; \
                        *(bf16x8*)(K_lds + (bf) * SHM_K + kws) = S_##_k0; *(bf16x8*)(K_lds + (bf) * SHM_K + kws + 32 * KROW) = S_##_k1; \
                        if constexpr (C::EXT) *(bf16x8*)(K_lds + (bf) * SHM_K + kwr) = S_##_kr; } while (0)
#define VMWN(n) asm volatile("s_waitcnt vmcnt(%0)" :: "i"(n) : "memory")
    bf16x8 qr[8];
    { const bf16* qp = q_row0<C>(cur, T) + (size_t)(wid * QBLK + r32) * ld + hi * 8;
#pragma unroll
      for (int d0 = 0; d0 < 8; ++d0) qr[d0] = load8(qp + d0 * 16); }
    if constexpr (C::EXT) {
#pragma unroll
        for (int d0 = 0; d0 < 4; ++d0) { const bf16x8 t = load8(T.QR + (size_t)(cur.row0 + cur.P0 + wid * QBLK + r32) * 1024 + cur.hd * 64 + d0 * 16 + hi * 8); *(bf16x8*)(QR_w + (d0 * 64 + lane) * 16) = t; }
    }
    SLOAD(s0, KBASE(0)); if (NT > 1) { SLOAD(s1, KBASE(1)); VMWN(NLD); } else { VMW(); } SWRITE(s0, 0);
    __syncthreads();
    float m_reg = -1e30f, l_reg = 0; f32x16 o[4] = {};
    f32x16 p0, p1; float mn, al; bf16x8 pa0, pa1, pa2, pa3;
#define STEP(t, BUF, SC_, SN_, FULL_) do {         \
        if (FULL_ || (t) + 2 < NT) { SLOAD(SC_, KBASE((t) + 2)); }                                                            \
        SBAR(); qkt<C, BUF>(p0, p1, K_lds, QR_w, lane, r32, hi, qr, ACT(t));                                                  \
        { const int kb_ = KBASE(t); if ((!SK || ACT(t)) && (kb_ + KVBLK - 1 > qlo || kb_ <= qlo + QBLK - 1 - W)) mask_tile(p0, p1, qm - kb_, (unsigned)W); } \
        partialSM<C>(p0, p1, m_reg, mn, al);                                                                                  \
        if (__any(al < 1.f)) { if (hi == 0) al_l[r32] = al; asm volatile("s_waitcnt lgkmcnt(0)" ::: "memory");              \
            for (int d_ = 0; d_ < 4; ++d_) for (int r = 0; r < 16; ++r) o[d_][r] *= al_l[crow(r, hi)]; }                      \
        finishSM(p0, p1, al, l_reg, pa0, pa1, pa2, pa3); SBAR();                                                              \
        pv_tile<C, BUF>(o, vb0, pa0, pa1, pa2, pa3, ACT(t));                                                                  \
        if (FULL_) { VMWN(NLD); SWRITE(SN_, (BUF) ^ 1); }                                                                     \
        else if ((t) + 1 < NT) { if ((t) + 2 < NT) { VMWN(NLD); } else { VMW(); } SWRITE(SN_, (BUF) ^ 1); }                   \
        __syncthreads(); } while (0)
    int t = 0;
    for (; t + 3 < NT; t += 2) { STEP(t, 0, s0, s1, true); STEP(t + 1, 1, s1, s0, true); }
    for (; t < NT; t += 2) { STEP(t, 0, s0, s1, false); if (t + 1 < NT) STEP(t + 1, 1, s1, s0, false); }
    if (hi == 0) li_l[r32] = l_reg; asm volatile("s_waitcnt lgkmcnt(0)" ::: "memory");
    if constexpr (C::LSEOUT) { if (hi == 0) cur.lse[(size_t)(cur.P0 + wid * QBLK + r32) * cur.ldl] = m_reg * SCALE + __logf(l_reg); }
    float rli[16];
#pragma unroll
    for (int r = 0; r < 16; ++r) rli[r] = __builtin_amdgcn_rcpf(li_l[crow(r, hi)]);
    char* Ost = lds + wid * 8192;
#pragma unroll
    for (int r = 0; r < 16; ++r) { const int orow = crow(r, hi);
#pragma unroll
        for (int d0 = 0; d0 < 4; ++d0) { const float v = o[d0][r] * rli[r];
            const float vn = __shfl_xor(v, 1);
            if ((r32 & 1) == 0) *(unsigned*)(Ost + orow * 256 + (d0 * 32 + r32) * 2) = cvtpk(v, vn); } }
    asm volatile("s_waitcnt lgkmcnt(0)" ::: "memory");
    bf16* Ow = o_row0<C>(cur, T) + (size_t)(wid * QBLK) * ld;
#pragma unroll
    for (int j = 0; j < 8; ++j) { const int ch = j * 64 + lane, row = ch >> 4, cc = ch & 15;
        const u32x4 val = *(const u32x4*)(Ost + row * 256 + cc * 16);
        *(u32x4*)(Ow + (size_t)row * ld + cc * 8) = val; }
    __syncthreads();
#undef KBASE
#undef ACT
#undef SLOAD
#undef SWRITE
#undef STEP
#undef VMWN
}
struct PF { bf16x8 q[8]; bf16x8 s[8]; };
template <class C>
__device__ __forceinline__ void pf_request(PF& pf, const Blk& b, const Tens& T, int W, const int wave_in) {
    int tid_ = wave_in * 64 + hw_lane(); asm volatile("" : "+v"(tid_));
    const int tid = tid_, wid = __builtin_amdgcn_readfirstlane(tid >> 6), lane = tid & 63, r32 = lane & 31, hi = lane >> 5, sr = tid >> 4, sc = (tid & 15) * 8;
    const int ldn = ld_of<C>(b); const bf16* kpn = k_row0<C>(b, T); const bf16* vpn = v_row0<C>(b, T); const int kb0 = swa_jlo(b.P0, W) * KVBLK;
    const bf16* qp = q_row0<C>(b, T) + (size_t)(wid * QBLK + r32) * ldn + hi * 8;
#pragma unroll
    for (int d0 = 0; d0 < 8; ++d0) pf.q[d0] = load8(qp + d0 * 16);
    pf.s[0] = load8(vpn + (size_t)(kb0 + sr) * ldn + sc); pf.s[1] = load8(vpn + (size_t)(kb0 + 32 + sr) * ldn + sc); pf.s[2] = load8(kpn + (size_t)(kb0 + sr) * ldn + sc); pf.s[3] = load8(kpn + (size_t)(kb0 + 32 + sr) * ldn + sc);
    pf.s[4] = load8(vpn + (size_t)(kb0 + 64 + sr) * ldn + sc); pf.s[5] = load8(vpn + (size_t)(kb0 + 96 + sr) * ldn + sc); pf.s[6] = load8(kpn + (size_t)(kb0 + 64 + sr) * ldn + sc); pf.s[7] = load8(kpn + (size_t)(kb0 + 96 + sr) * ldn + sc);
}
template <class C>
__device__ __forceinline__ void attn_block_pf(const Blk& cur, const Tens& T, int skv, int W, char* lds, const int wave_in, PF& pf, const bool pf_valid, const Blk& nxt, const int skv_n, const bool has_next) {
    static_assert(!C::EXT, "prefetching variant: plain D = 128 blocks only");
    constexpr int KROW = Geo<C>::KROW, SHM_K = Geo<C>::SHM_K; constexpr bool SK = C::SK; constexpr float SCALE = C::SCALE;
    int tid_ = wave_in * 64 + hw_lane(); asm volatile("" : "+v"(tid_));
    const int tid = tid_, wid = __builtin_amdgcn_readfirstlane(tid >> 6), lane = tid & 63, r32 = lane & 31, hi = lane >> 5;
    const int j_lo = swa_jlo(cur.P0, W);
    int j_hi = (cur.P0 + QB - 1) / KVBLK + 1; if (j_hi > skv / KVBLK) j_hi = skv / KVBLK;
    const int NT = j_hi - j_lo;
    const int qlo = cur.P0 + wid * QBLK, qm = qlo + r32 - 4 * hi;
    char* V_lds = lds; char* K_lds = lds + Geo<C>::OFF_K;
    float* ws = (float*)(lds + Geo<C>::OFF_WS) + wid * 64; float* li_l = ws, * al_l = ws + 32;
    char* QR_w = lds + Geo<C>::OFF_QR + wid * 4096;
    const int sr = tid >> 4, sc = (tid & 15) * 8, vst0 = v_st(sr, sc), vst1 = v_st(32 + sr, sc), kws = KSWZ(sr, sc * 2);
    const int rr8 = tid >> 3, rc8 = (tid & 7) * 8, kwr = KSWZ(rr8, 256 + rc8 * 2);
    (void)kwr; (void)rr8; (void)rc8; (void)QR_w;
    const int vb0 = (int)(uintptr_t)V_lds + v_rd_base(lane);
    const bf16* kp = k_row0<C>(cur, T); const bf16* vp = v_row0<C>(cur, T); const int ld = ld_of<C>(cur);
    bf16x8& s0_v0 = pf.s[0]; bf16x8& s0_v1 = pf.s[1]; bf16x8& s0_k0 = pf.s[2]; bf16x8& s0_k1 = pf.s[3]; bf16x8& s1_v0 = pf.s[4]; bf16x8& s1_v1 = pf.s[5]; bf16x8& s1_k0 = pf.s[6]; bf16x8& s1_k1 = pf.s[7]; bf16x8 s0_kr, s1_kr; (void)s0_kr; (void)s1_kr;
    constexpr int NLD = C::EXT ? 5 : 4;
#define KBASE(t) ((j_lo + (t)) * KVBLK)
#define ACT(t) (KBASE(t) <= qlo + QBLK - 1 && KBASE(t) + KVBLK - 1 >= qlo - W + 1)
#define SLOAD(S_, k0) do { S_##_v0 = load8(vp + (size_t)((k0) + sr) * ld + sc); S_##_v1 = load8(vp + (size_t)((k0) + 32 + sr) * ld + sc); \
                       S_##_k0 = load8(kp + (size_t)((k0) + sr) * ld + sc); S_##_k1 = load8(kp + (size_t)((k0) + 32 + sr) * ld + sc); \
                       if constexpr (C::EXT) S_##_kr = load8(T.KR + (size_t)(cur.row0 + (k0) + rr8) * 64 + rc8); } while (0)
#define SWRITE(S_, bf) do { *(bf16x8*)(V_lds + (bf) * SHM_V + vst0) = S_##_v0; *(bf16x8*)(V_lds + (bf) * SHM_V + vst1) = S_##_v1; \
                        *(bf16x8*)(K_lds + (bf) * SHM_K + kws) = S_##_k0; *(bf16x8*)(K_lds + (bf) * SHM_K + kws + 32 * KROW) = S_##_k1; \
                        if constexpr (C::EXT) *(bf16x8*)(K_lds + (bf) * SHM_K + kwr) = S_##_kr; } while (0)
#define VMWN(n) asm volatile("s_waitcnt vmcnt(%0)" :: "i"(n) : "memory")
    bf16x8 (&qr)[8] = pf.q; (void)pf_valid;
    VMWN(NLD); SWRITE(s0, 0);
    __syncthreads();
    float m_reg = -1e30f, l_reg = 0; f32x16 o[4] = {};
    f32x16 p0, p1; float mn, al; bf16x8 pa0, pa1, pa2, pa3;
#define STEP(t, BUF, SC_, SN_, FULL_) do {         \
        if (FULL_ || (t) + 2 < NT) { SLOAD(SC_, KBASE((t) + 2)); }                                                            \
        SBAR(); qkt<C, BUF>(p0, p1, K_lds, QR_w, lane, r32, hi, qr, ACT(t));                                                  \
        { const int kb_ = KBASE(t); if ((!SK || ACT(t)) && (kb_ + KVBLK - 1 > qlo || kb_ <= qlo + QBLK - 1 - W)) mask_tile(p0, p1, qm - kb_, (unsigned)W); } \
        partialSM<C>(p0, p1, m_reg, mn, al);                                                                                  \
        if (__any(al < 1.f)) { if (hi == 0) al_l[r32] = al; asm volatile("s_waitcnt lgkmcnt(0)" ::: "memory");              \
            for (int d_ = 0; d_ < 4; ++d_) for (int r = 0; r < 16; ++r) o[d_][r] *= al_l[crow(r, hi)]; }                      \
        finishSM(p0, p1, al, l_reg, pa0, pa1, pa2, pa3); SBAR();                                                              \
        pv_tile<C, BUF>(o, vb0, pa0, pa1, pa2, pa3, ACT(t));                                                                  \
        if (FULL_) { VMWN(NLD); SWRITE(SN_, (BUF) ^ 1); }                                                                     \
        else if ((t) + 1 < NT) { if ((t) + 2 < NT) { VMWN(NLD); } else { VMW(); } SWRITE(SN_, (BUF) ^ 1); }                   \
        __syncthreads(); } while (0)
    int t = 0;
    for (; t + 3 < NT; t += 2) { STEP(t, 0, s0, s1, true); STEP(t + 1, 1, s1, s0, true); }
    for (; t < NT; t += 2) { STEP(t, 0, s0, s1, false); if (t + 1 < NT) STEP(t + 1, 1, s1, s0, false); }
    if (has_next) pf_request<C>(pf, nxt, T, W, wave_in);
    (void)skv_n;
    if (hi == 0) li_l[r32] = l_reg; asm volatile("s_waitcnt lgkmcnt(0)" ::: "memory");
    if constexpr (C::LSEOUT) { if (hi == 0) cur.lse[(size_t)(cur.P0 + wid * QBLK + r32) * cur.ldl] = m_reg * SCALE + __logf(l_reg); }
    float rli[16];
#pragma unroll
    for (int r = 0; r < 16; ++r) rli[r] = __builtin_amdgcn_rcpf(li_l[crow(r, hi)]);
    char* Ost = lds + wid * 8192;
#pragma unroll
    for (int r = 0; r < 16; ++r) { const int orow = crow(r, hi);
#pragma unroll
        for (int d0 = 0; d0 < 4; ++d0) { const float v = o[d0][r] * rli[r];
            const float vn = __shfl_xor(v, 1);
            if ((r32 & 1) == 0) *(unsigned*)(Ost + orow * 256 + (d0 * 32 + r32) * 2) = cvtpk(v, vn); } }
    asm volatile("s_waitcnt lgkmcnt(0)" ::: "memory");
    bf16* Ow = o_row0<C>(cur, T) + (size_t)(wid * QBLK) * ld;
#pragma unroll
    for (int j = 0; j < 8; ++j) { const int ch = j * 64 + lane, row = ch >> 4, cc = ch & 15;
        const u32x4 val = *(const u32x4*)(Ost + row * 256 + cc * 16);
        *(u32x4*)(Ow + (size_t)row * ld + cc * 8) = val; }
    __syncthreads();
#undef KBASE
#undef ACT
#undef SLOAD
#undef SWRITE
#undef STEP
#undef VMWN
}
#undef VMW
#undef KSWZ
#undef SBAR
}
#define GAS __attribute__((address_space(1)))
#define LAS __attribute__((address_space(3)))
typedef unsigned short bf16;
typedef unsigned v4u __attribute__((ext_vector_type(4)));
typedef float f32x4 __attribute__((ext_vector_type(4)));
typedef short bf16x8 __attribute__((ext_vector_type(8)));
typedef GAS unsigned gu32;
typedef GAS unsigned long long gu64;
#define RLX_AGENT __ATOMIC_RELAXED, __HIP_MEMORY_SCOPE_AGENT
#define LDS_WAIT() asm volatile("s_waitcnt lgkmcnt(0)" ::: "memory")
#define VM_WAIT() asm volatile("s_waitcnt vmcnt(0)" ::: "memory")
__device__ __forceinline__ unsigned long long rt() { return __builtin_amdgcn_s_memrealtime(); }
__device__ __forceinline__ unsigned f2bf(float f) { unsigned u = __builtin_bit_cast(unsigned, f); return (u + 0x7fffu + ((u >> 16) & 1u)) >> 16; }
__device__ __forceinline__ unsigned pk2(float lo, float hi) { return f2bf(lo) | (f2bf(hi) << 16); }

#define XB_TMO      128
#define XB_XCNT(j)  (256  + 64 * (j))
#define XB_XSUB(j)  (1280 + 64 * (j))
#define XB_XGEN(j)  (2304 + 64 * (j))
#define XB_TOP      3328
#define XB_TOPGEN   3392
#define XCD_BAR_WORDS 3456
#define XB_SPIN_CAP (1u << 18)

__device__ __forceinline__ unsigned xb_ld(unsigned* p)              { return __hip_atomic_load(p, __ATOMIC_RELAXED, __HIP_MEMORY_SCOPE_AGENT); }
__device__ __forceinline__ unsigned xb_add(unsigned* p, unsigned v) { return __hip_atomic_fetch_add(p, v, __ATOMIC_RELAXED, __HIP_MEMORY_SCOPE_AGENT); }
__device__ __forceinline__ unsigned xb_xcc_id() { return (unsigned)__builtin_amdgcn_s_getreg((3 << 11) | 20) & 0xFu; }
#define XB_SPIN(cond, bar) do { unsigned _sp = 0; while (cond) { __builtin_amdgcn_s_sleep(1); \
    if ((++_sp & 255u) == 0u) { if (xb_ld(&(bar)[XB_TMO])) break; if (_sp > XB_SPIN_CAP) { atomicAdd(&(bar)[XB_TMO], 1u); break; } } } } while (0)

struct XcdBarrier {
    unsigned* bar; unsigned x;
    volatile LAS unsigned* st;
};

__device__ __forceinline__ XcdBarrier xcd_barrier_post(unsigned* bar, volatile LAS unsigned* st, const bool thread0) {
    XcdBarrier b; b.bar = bar; b.x = xb_xcc_id(); b.st = st;
    if (thread0) (void)xb_add(&bar[XB_XCNT(b.x)], 1u);
    return b;
}
__device__ __forceinline__ void xcd_barrier_complete(unsigned* bar, unsigned x, unsigned& nloc, unsigned& nx) {
    const unsigned G = gridDim.x * gridDim.y * gridDim.z;
    unsigned sum, cnt, mine, sp = 0u;
    for (;;) {
        sum = 0u; cnt = 0u; mine = 0u;
#pragma unroll
        for (unsigned j = 0; j < 16; ++j) { const unsigned c = xb_ld(&bar[XB_XCNT(j)]); sum += c; cnt += (c > 0u) ? 1u : 0u; mine = (j == x) ? c : mine; }
        if (sum == G) break;
        __builtin_amdgcn_s_sleep(1);
        if ((++sp & 255u) == 0u) { if (xb_ld(&bar[XB_TMO])) break; if (sp > XB_SPIN_CAP) { atomicAdd(&bar[XB_TMO], 1u); break; } }
    }
    nloc = mine > 0u ? mine : 1u; nx = cnt > 0u ? cnt : 1u;
}

__device__ __forceinline__ void xcd_barrier(const XcdBarrier& b, const bool thread0) {
    asm volatile("s_waitcnt vmcnt(0)" ::: "memory");
    __syncthreads();
    if (thread0) {
        unsigned* bar = b.bar;
        __builtin_amdgcn_s_waitcnt(0);
        unsigned nloc = b.st[0], nx = b.st[1];
        if (nloc == 0u) { xcd_barrier_complete(bar, b.x, nloc, nx); b.st[0] = nloc; b.st[1] = nx; }
        const unsigned old = xb_add(&bar[XB_XSUB(b.x)], 1u);
        const unsigned gen = old / nloc;
        if (old + 1u == (gen + 1u) * nloc) {
            __builtin_amdgcn_fence(__ATOMIC_RELEASE, "agent");
            asm volatile("s_waitcnt vmcnt(0)" ::: "memory");
            const unsigned og = xb_add(&bar[XB_TOP], 1u);
            const unsigned tg = og / nx;
            if (og + 1u == (tg + 1u) * nx) xb_add(&bar[XB_TOPGEN], 1u);
            else XB_SPIN(xb_ld(&bar[XB_TOPGEN]) == tg, bar);
            __builtin_amdgcn_fence(__ATOMIC_ACQUIRE, "agent");
            xb_add(&bar[XB_XGEN(b.x)], 1u);
            asm volatile("s_waitcnt vmcnt(0)" ::: "memory");
        } else {
            XB_SPIN(xb_ld(&bar[XB_XGEN(b.x)]) == gen, bar);
            __builtin_amdgcn_fence(__ATOMIC_ACQUIRE, "agent");
            asm volatile("s_waitcnt vmcnt(0)" ::: "memory");
        }
    }
    __syncthreads();
}
#ifndef FP8_A1
#define FP8_A1 0
#endif
#ifndef CLK_PROBE
#define CLK_PROBE 0
#endif
#ifndef CLK_PROBE_STEP
#define CLK_PROBE_STEP 0
#endif
#ifndef DUP_OUT
#define DUP_OUT 1
#endif
#ifndef DUP_EW
#define DUP_EW 1
#endif
#ifndef DUP_SMALLG
#define DUP_SMALLG 1
#endif
#ifndef F2_WGM
#define F2_WGM 4
#endif
#ifndef DUP_CONV
#define DUP_CONV 1
#endif
#ifndef DUP_F1
#define DUP_F1 1
#endif
#ifndef DUP_F2
#define DUP_F2 1
#endif
#ifndef DUP_A1
#define DUP_A1 1
#endif
#ifndef DUP_A12
#define DUP_A12 1
#endif
#ifndef DUP_B4
#define DUP_B4 1
#endif
#ifndef EN_CONV
#define EN_CONV 1
#endif
#ifndef EN_F1
#define EN_F1 1
#endif
#ifndef EN_F2
#define EN_F2 1
#endif
#ifndef EN_A1
#define EN_A1 1
#endif
#ifndef EN_A2
#define EN_A2 1
#endif
#ifndef EN_A3
#define EN_A3 1
#endif
#ifndef EN_B1
#define EN_B1 1
#endif
#ifndef EN_B23
#define EN_B23 1
#endif
#ifndef EN_B4
#define EN_B4 1
#endif
#ifndef EN_C1
#define EN_C1 1
#endif
#ifndef EN_C2
#define EN_C2 1
#endif
#ifndef EN_OUT
#define EN_OUT 1
#endif
constexpr int NWAVES = 8;
#ifndef MK_PER_PHASE
#define MK_PER_PHASE 0
#endif
constexpr int BATCH = 2, SEQ = 8192, DM = 2048, DFF = 5632, M = BATCH * SEQ;
constexpr int NQKV = 18432;
constexpr int BQ = 1536, BKV = 512, BR = 64, BIN_PAD = 2304;
constexpr size_t MiB = 1u << 20;
constexpr size_t WS_CTL = 0, CTL_ZERO_BYTES = 1 * MiB;
constexpr size_t WS_COSA = 1 * MiB, WS_SINA = 2 * MiB, WS_COSB = 3 * MiB, WS_SINB = 5 * MiB;
constexpr size_t WS_SS = 7 * MiB, WS_SSQ = 9 * MiB, WS_SSKV = 11 * MiB, WS_LSE = 12 * MiB;
constexpr size_t WS_H32 = 16 * MiB, WS_HB = 144 * MiB, WS_OC = 208 * MiB, WS_BIG = 272 * MiB, WS_W = 848 * MiB, WS_WSTRIDE = 0, WS_END = 1076 * MiB;
constexpr size_t BG_CQ = 0, BG_CKV = 48 * MiB, BG_KR = 64 * MiB, BG_QN = 66 * MiB, BG_QR = 130 * MiB, BG_KN = 162 * MiB, BG_VB = 226 * MiB;
constexpr size_t BG_CU = 0, BG_BGATE = 64 * MiB;
constexpr size_t WE_AV8 = 69206016 + 25165824;
constexpr size_t WE_13A = 0, WE_2A = 23068672, WE_13B = 34603008, WE_2B = 57671680, WE_MIX0 = 69206016, WE_MIX1 = 106954752, WE_MIX2 = 111673344, WE_MIX3 = 113770496, WE_END = 117964800;
static_assert(WS_W + WE_END * 2 <= WS_END, "weights fit");
constexpr int CW_BAR = 4096;
constexpr int RING_OFF = 0, RING_BYTES = 131072;
constexpr int LDSCTL_OFF = RING_BYTES, MISC_OFF = LDSCTL_OFF + 320;
constexpr int LDS_BYTES = 147456;
static_assert(att::Geo<att::CfgB>::LDS_BYTES <= RING_BYTES && att::Geo<att::CfgA>::LDS_BYTES <= RING_BYTES, "attention LDS fits the ring");

struct Args { const float* in[44]; float* out; unsigned char* ws; float invA[16]; float invB[32]; int ph_lo, ph_hi, use_bar, pad; };

__device__ __forceinline__ int layer_base(int L) { return L == 0 ? 2 : (L == 1 ? 11 : (L == 2 ? 24 : 34)); }
__device__ __forceinline__ float wave_sum(float v) {
#pragma unroll
    for (int o = 1; o < 64; o <<= 1) v += __shfl_xor(v, o);
    return v;
}
enum { MAP_ID = 0, MAP_FFN = 1, MAP_AQKV = 2, MAP_BIN = 3, MAP_BUQ = 4, MAP_CIN = 5, MAP_AQK = 6, MAP_AV = 7 };
__device__ __forceinline__ int map_col(int kind, int n) {
    switch (kind) {
    case MAP_FFN:  { const int pn = n >> 8, bj = (n >> 7) & 1, j = n & 127; return bj * DFF + pn * 128 + j; }
    case MAP_AQKV: { const int d = n & 127, t = (n >> 11) % 3; if (t < 2 && d < 32) { const int fqq = d >> 3, r = d & 7; return (n - d) + (r < 4 ? 4 * fqq + r : 16 + 4 * fqq + (r - 4)); } return n; }
    case MAP_AQK:  { const int gq = n >> 12, rem = n & 4095; return map_col(MAP_AQKV, gq * 6144 + rem); }
    case MAP_AV:   { return (n >> 11) * 6144 + 4096 + (n & 2047); }
    case MAP_BIN:  { if (n < 2048) return n; const int c = n - 2048; if (c < 32) return 2048 + c; if (c >= 128 && c < 160) return 2048 + 32 + (c - 128); return -1; }
    case MAP_BUQ:  { if (n < 2048) { const int head = n >> 7, d = n & 127; return head * 192 + d; } const int tt = (n - 2048) >> 8, bj = (n >> 7) & 1, c = n & 127; return (tt * 4 + (c >> 5)) * 192 + 128 + (c & 31) + 32 * bj; }
    case MAP_CIN:  { if (n < 4096) { const int pn = n >> 8, bj = (n >> 7) & 1, j = n & 127; return 2048 + bj * 2048 + pn * 128 + j; } return n - 4096; }
    default: return n;
    }
}
__device__ __forceinline__ void conv_item(const float* W, int K, int Nsrc, bf16* WT, int Ndst, int kind, const float* gain, float f8, LAS float* scr, int item, int lane) {
    const int nblk = Ndst >> 5, kb = item / nblk, nb = item - kb * nblk, k0 = 64 * kb, n0 = 32 * nb;
    const int scol = map_col(kind, n0 + (lane & 31));
    const float* src = W + (size_t)(k0 + (lane >> 5)) * Nsrc + (scol < 0 ? 0 : scol);
#pragma unroll 8
    for (int i = 0; i < 32; ++i) { float v = __builtin_nontemporal_load(src + (size_t)(2 * i) * Nsrc);     if (scol < 0) v = 0.f; scr[(2 * i + (lane >> 5)) * 33 + (lane & 31)] = v; }
    LDS_WAIT(); asm volatile("" ::: "memory");
    const int c = lane & 7;
    f32x4 g0 = {1.f, 1.f, 1.f, 1.f}, g1 = {1.f, 1.f, 1.f, 1.f};
    if (gain) { g0 = *(const f32x4*)(gain + k0 + 8 * c); g1 = *(const f32x4*)(gain + k0 + 8 * c + 4); }
#pragma unroll
    for (int j = 0; j < 4; ++j) { const int n = (lane >> 3) + 8 * j; const LAS float* s = scr + (8 * c) * 33 + n;
        if (f8 > 0.f) { const f32x4 a = {s[0 * 33] * g0[0] * f8, s[1 * 33] * g0[1] * f8, s[2 * 33] * g0[2] * f8, s[3 * 33] * g0[3] * f8}, b = {s[4 * 33] * g1[0] * f8, s[5 * 33] * g1[1] * f8, s[6 * 33] * g1[2] * f8, s[7 * 33] * g1[3] * f8};
            *(pg8::u32x2*)((unsigned char*)WT + (size_t)(n0 + n) * K + k0 + 8 * c) = pg8::pack8f8(a, b); }
        else if (f8 < 0.f) { v4u o; o.x = pg8::pkh2(s[0 * 33] * g0[0], s[1 * 33] * g0[1]); o.y = pg8::pkh2(s[2 * 33] * g0[2], s[3 * 33] * g0[3]); o.z = pg8::pkh2(s[4 * 33] * g1[0], s[5 * 33] * g1[1]); o.w = pg8::pkh2(s[6 * 33] * g1[2], s[7 * 33] * g1[3]);
            *(v4u*)(WT + (size_t)(n0 + n) * K + k0 + 8 * c) = o; }
        else { v4u o; o.x = pk2(s[0 * 33] * g0[0], s[1 * 33] * g0[1]); o.y = pk2(s[2 * 33] * g0[2], s[3 * 33] * g0[3]); o.z = pk2(s[4 * 33] * g1[0], s[5 * 33] * g1[1]); o.w = pk2(s[6 * 33] * g1[2], s[7 * 33] * g1[3]);
        *(v4u*)(WT + (size_t)(n0 + n) * K + k0 + 8 * c) = o; } }
    LDS_WAIT(); asm volatile("" ::: "memory");
}
__device__ __forceinline__ int conv_job(const float* W, int K, int Nsrc, bf16* WT, int Ndst, int kind, const float* gain, float f8, LAS float* scr, int lane, int gw, int NGW, int base) {
    const int nitems = (K >> 6) * (Ndst >> 5);
    int first = (gw - base) % NGW; if (first < 0) first += NGW;
    for (int it = first; it < nitems; it += NGW) conv_item(W, K, Nsrc, WT, Ndst, kind, gain, f8, scr, it, lane);
    return base + nitems;
}
constexpr float HFMT = 0.f;
struct ConvJob { int src, K, Nsrc, Ndst, map, gain; unsigned dst; float f8; };
__device__ __forceinline__ ConvJob conv_job_desc(int li, int kind, int jb) {
    const int n2 = li + (kind == 0 ? 6 : (kind == 1 ? 10 : 7));
    ConvJob J;
    switch (jb) {
    case 0:  J = ConvJob{li + 1, DM, 2 * DFF, 2 * DFF, MAP_FFN, li, (unsigned)WE_13A, HFMT}; break;
    case 1:  J = ConvJob{li + 2, DFF, DM, DM, MAP_ID, -1, (unsigned)WE_2A, 0.f}; break;
    case 2:  J = ConvJob{n2 + 1, DM, 2 * DFF, 2 * DFF, MAP_FFN, n2, (unsigned)WE_13B, HFMT}; break;
    case 3:  J = ConvJob{n2 + 2, DFF, DM, DM, MAP_ID, -1, (unsigned)WE_2B, 0.f}; break;
    case 4:  if (kind == 0) J = FP8_A1 ? ConvJob{li + 4, DM, NQKV, 12288, MAP_AQK, li + 3, (unsigned)WE_MIX0, 0.f} : ConvJob{li + 4, DM, NQKV, NQKV, MAP_AQKV, li + 3, (unsigned)WE_MIX0, HFMT};
             else if (kind == 1) J = ConvJob{li + 4, DM, BQ + BKV + BR, BIN_PAD, MAP_BIN, li + 3, (unsigned)WE_MIX0, HFMT};
             else J = ConvJob{li + 4, DM, 3 * DM, 3 * DM, MAP_CIN, li + 3, (unsigned)WE_MIX0, HFMT};
             break;
    case 5:  if (kind == 1) J = ConvJob{li + 6, BQ, 3072, 3072, MAP_BUQ, li + 5, (unsigned)WE_MIX1, 0.f};
             else J = ConvJob{li + (kind == 0 ? 5 : 6), DM, DM, DM, MAP_ID, -1, (unsigned)WE_MIX1, 0.f};
             break;
    case 6:  if (kind == 0) J = ConvJob{li + 4, DM, NQKV, 6144, MAP_AV, li + 3, (unsigned)WE_AV8, 64.f};
             else J = ConvJob{li + 8, BKV, 4096, 4096, MAP_ID, li + 7, (unsigned)WE_MIX2, 0.f};
             break;
    default: J = ConvJob{li + 9, DM, DM, DM, MAP_ID, -1, (unsigned)WE_MIX3, 0.f}; break;
    }
    return J;
}
#define CONV_LAYER(L_) do { WSP_DECL; bf16* WBc_ = WB0 + (size_t)((L_) & 1) * (WS_WSTRIDE / 2); int lane_ = LANE(); asm volatile("" : "+v"(lane_)); const int li_ = layer_base(L_), kind_ = (L_) % 3, njobs_ = (kind_ == 1) ? 8 : ((kind_ == 0 && FP8_A1) ? 7 : 6); int base_ = 0; \
    for (int jb_ = 0; jb_ < njobs_; ++jb_) { const ConvJob J_ = conv_job_desc(li_, kind_, jb_); const float* gain_ = (J_.gain >= 0) ? args.in[J_.gain] : nullptr; \
        base_ = conv_job(args.in[J_.src], J_.K, J_.Nsrc, WBc_ + J_.dst, J_.Ndst, J_.map, gain_, J_.f8, scr, lane_, gw, NGW, base_); } } while (0)
__device__ __forceinline__ void sincos_d(double a, float& sn, float& cs) {
    const double k = __builtin_rint(a * 0.15915494309189533577);
    double r = __builtin_fma(-k, 6.28318530717958623200, a); r = __builtin_fma(-k, 2.4492935982947064e-16, r);
    const double r2 = r * r;
    double s = -1.0 / 51090942171709440000.0;
    s = s * r2 + 1.0 / 121645100408832000.0;
    s = s * r2 - 1.0 / 355687428096000.0;
    s = s * r2 + 1.0 / 1307674368000.0;
    s = s * r2 - 1.0 / 6227020800.0;
    s = s * r2 + 1.0 / 39916800.0;
    s = s * r2 - 1.0 / 362880.0;
    s = s * r2 + 1.0 / 5040.0;
    s = s * r2 - 1.0 / 120.0;
    s = s * r2 + 1.0 / 6.0;
    s = r - r * r2 * s;
    double c = 1.0 / 1124000727777607680000.0;
    c = c * r2 - 1.0 / 2432902008176640000.0;
    c = c * r2 + 1.0 / 6402373705728000.0;
    c = c * r2 - 1.0 / 20922789888000.0;
    c = c * r2 + 1.0 / 87178291200.0;
    c = c * r2 - 1.0 / 479001600.0;
    c = c * r2 + 1.0 / 3628800.0;
    c = c * r2 - 1.0 / 40320.0;
    c = c * r2 + 1.0 / 720.0;
    c = c * r2 - 1.0 / 24.0;
    c = c * r2 + 0.5;
    c = 1.0 - r2 * c;
    sn = (float)s; cs = (float)c;
}

__device__ __forceinline__ int lane_opaque() { int t = hw_lane(); asm volatile("" : "+v"(t)); return t; }
template <int NPART> __device__ __forceinline__ void fill_rstd(LAS float* tab, const float* SSp, int stride, float inv_n, int pm, int wave) {
    const int ln = hw_lane(), rw = pm * 256 + wave * 32 + (ln & 31); const float* p = SSp + (size_t)rw * stride + (ln >> 5) * (NPART / 2); float sm = 0.f;
#pragma unroll
    for (int k = 0; k < NPART / 8; ++k) { const f32x4 a = *(const f32x4*)(p + 4 * k); sm += (a[0] + a[1]) + (a[2] + a[3]); }
    sm += __shfl_xor(sm, 32);
    if (ln < 32) tab[wave * 32 + ln] = 1.0f / sqrtf(sm * inv_n + 1e-6f);
}
#define RSTD_TABLE(NPART_, SSP_, STRIDE_, INVN_) LAS float* rsl = (LAS float*)(lds + LDSCTL_OFF + 4096); { pg8::Unit u0_; u0_.pm = 0; u0_.pn = 0; (void)S.next(0, u0_); fill_rstd<NPART_>(rsl, SSP_, STRIDE_, INVN_, u0_.pm, wave); } __syncthreads()
__global__ void __launch_bounds__(NWAVES * 64, 2) mk_fwd(Args args) {
    extern __shared__ __attribute__((aligned(16))) unsigned char lds_raw[];
    LAS unsigned char* lds = (LAS unsigned char*)lds_raw;
    volatile LAS unsigned* MISC = (volatile LAS unsigned*)(lds + MISC_OFF);
    const int wave = __builtin_amdgcn_readfirstlane((int)(threadIdx.x >> 6));
#define tid (wave * 64 + hw_lane())
#define T0 (wave == 0 && hw_lane() == 0)
#define LANE() lane_opaque()
    const int G = gridDim.x; const int bx = blockIdx.x; const int vcu = (G % 8 == 0) ? (bx % 8) * (G / 8) + bx / 8 : bx;
    const int gw = vcu * NWAVES + wave, NGW = G * NWAVES;
#define WSP_DECL GAS unsigned char* wsp = (GAS unsigned char*)args.ws; asm volatile("" : "+s"(wsp))
#define cosA ((float*)(wsp + WS_COSA))
#define sinA ((float*)(wsp + WS_SINA))
#define cosB ((float*)(wsp + WS_COSB))
#define sinB ((float*)(wsp + WS_SINB))
#define SS ((float*)(wsp + WS_SS))
#define SSQ ((float*)(wsp + WS_SSQ))
#define SSKV ((float*)(wsp + WS_SSKV))
#define LSE ((float*)(wsp + WS_LSE))
#define HLO ((bf16*)(wsp + WS_H32))
#define HB ((bf16*)(wsp + WS_HB))
#define OC ((bf16*)(wsp + WS_OC))
#define HB8 ((unsigned char*)(wsp + 80 * MiB))
#define BIG ((unsigned char*)(wsp + WS_BIG))
#define WB0 ((bf16*)(wsp + WS_W))
#define WB WB0
#define HID ((bf16*)BIG)
#define QKV ((bf16*)BIG)
#define CQ ((bf16*)(BIG + BG_CQ))
#define CKV ((bf16*)(BIG + BG_CKV))
#define KR ((bf16*)(BIG + BG_KR))
#define QN ((bf16*)(BIG + BG_QN))
#define QRo ((bf16*)(BIG + BG_QR))
#define KN ((bf16*)(BIG + BG_KN))
#define VB ((bf16*)(BIG + BG_VB))
#define CU ((bf16*)(BIG + BG_CU))
#define BGt ((bf16*)(BIG + BG_BGATE))
    unsigned* ctl = (unsigned*)(args.ws + WS_CTL);
    for (int u = tid; u < (LDS_BYTES - LDSCTL_OFF) / 4; u += NWAVES * 64) ((LAS unsigned*)(lds + LDSCTL_OFF))[u] = 0u;
    __syncthreads();
    XcdBarrier bar; bar.bar = ctl + CW_BAR; bar.x = 0; bar.st = nullptr;
    if (args.use_bar) bar = xcd_barrier_post(ctl + CW_BAR, MISC + 8, T0);
    const int lo = args.ph_lo, hi = args.ph_hi;
    int ph = 0;
#define IN_PH() (lo <= ph && ph < hi)
#if CLK_PROBE == 2
#define SEAM() do { if (lo <= ph && ph + 1 < hi) { const unsigned long long tb0_ = __builtin_amdgcn_s_memrealtime(); xcd_barrier(bar, T0); if (tid == 0) MISC[20] += (unsigned)(__builtin_amdgcn_s_memrealtime() - tb0_); } ++ph; } while (0)
#else
#define SEAM() do { if (lo <= ph && ph + 1 < hi) xcd_barrier(bar, T0); ++ph; } while (0)
#endif
    LAS float* scr = (LAS float*)(lds + RING_OFF + wave * 16384);

    if (IN_PH()) { WSP_DECL;
        const float* x = args.in[0]; const int* pos = (const int*)args.in[1]; const int lane = LANE();
        for (int m = gw; m < M; m += NGW) {
            const f32x4* xr = (const f32x4*)(x + (size_t)m * DM) + lane; float s = 0.f;
            unsigned long long* o8 = (unsigned long long*)(HB + (size_t)m * DM) + lane; unsigned long long* l8 = (unsigned long long*)(HLO + (size_t)m * DM) + lane;
#pragma unroll
            for (int j = 0; j < 8; ++j) { const f32x4 v = xr[64 * j]; s += (v[0] * v[0] + v[1] * v[1]) + (v[2] * v[2] + v[3] * v[3]);
                const unsigned w0 = pk2(v[0], v[1]), w1 = pk2(v[2], v[3]);
                o8[64 * j] = (unsigned long long)w0 | ((unsigned long long)w1 << 32);
                if (RES_MODE == 0) l8[64 * j] = (unsigned long long)pk2(v[0] - __uint_as_float(w0 << 16), v[1] - __uint_as_float(w0 & 0xffff0000u)) | ((unsigned long long)pk2(v[2] - __uint_as_float(w1 << 16), v[3] - __uint_as_float(w1 & 0xffff0000u)) << 32);
                if (RES_MODE == 2) l8[64 * j] = (unsigned long long)pg8::pkh2(v[0], v[1]) | ((unsigned long long)pg8::pkh2(v[2], v[3]) << 32); }
            s = wave_sum(s);
            if (lane < 32) SS[(size_t)m * 32 + lane] = (lane == 0) ? s : 0.f;
        }
        for (int i = gw * 64 + lane; i < M * 48; i += NGW * 64) {
            const int m = i / 48, j = i - m * 48; const float p = (float)pos[m];
            if (j < 16) { const float ang = p * args.invA[j]; float sn, cs; sincos_d((double)ang, sn, cs); cosA[m * 16 + j] = cs; sinA[m * 16 + j] = sn; }
            else { const int jj = j - 16; const float ang = p * args.invB[jj]; float sn, cs; sincos_d((double)ang, sn, cs); cosB[m * 32 + jj] = cs; sinB[m * 32 + jj] = sn; }
        }
#if EN_CONV
        for (int rep_ = 0; rep_ < DUP_CONV; ++rep_) { CONV_LAYER(0); }
#endif
    }
    SEAM();

    for (int s = 0; s < 12; ++s) {
        const int L = s / 3, r = s - 3 * L, kind = L % 3;
        if (r == 0 && L > 0) {
#if EN_CONV
            if (IN_PH()) for (int rep_ = 0; rep_ < DUP_CONV; ++rep_) { CONV_LAYER(L); }
#endif
            SEAM(); }
        if (r != 1) {
#if CLK_PROBE
            if (s == CLK_PROBE_STEP && r != 1 && bx == 0 && tid == 0 && CLK_PROBE == 1) { MISC[16] = (unsigned)__builtin_amdgcn_s_memtime(); MISC[17] = (unsigned)(__builtin_amdgcn_s_memtime() >> 32); MISC[18] = (unsigned)__builtin_amdgcn_s_memrealtime(); }
#endif
#if EN_F1
            for (int rep_ = 0; rep_ < DUP_F1; ++rep_) if (IN_PH()) { WSP_DECL; const bf16* ga_ = HB; const bf16* gb_ = WB + (r == 0 ? WE_13A : WE_13B); asm volatile("" : "+s"(ga_), "+s"(gb_)); pg8::Gemm g{ga_, gb_, M, 2 * DFF, DM}; pg8::StaticOrder S; S.init(M, 2 * DFF, G, bx);
                RSTD_TABLE(32, SS, 32, 1.0f / 2048.0f);
                pg8::EpiSwiGLU E{HID, DFF, rsl};
                pg8::gemm_phase<pg8::EpiSwiGLU, pg8::StaticOrder, true, true>(lds + RING_OFF, g, S, E, wave); }
#endif
#if CLK_PROBE
            if (s == CLK_PROBE_STEP && r != 1 && bx == 0 && tid == 0 && CLK_PROBE == 1) { const unsigned long long c1 = __builtin_amdgcn_s_memtime(); const unsigned w1 = (unsigned)__builtin_amdgcn_s_memrealtime(); const unsigned long long c0 = ((unsigned long long)MISC[17] << 32) | MISC[16]; MISC[19] = (unsigned)((c1 - c0) * 100ull / (unsigned long long)(w1 - MISC[18])); }
#endif
            SEAM();
#if EN_F2
            if (IN_PH()) { WSP_DECL; const bf16* ga_ = HID; const bf16* gb_ = WB + (r == 0 ? WE_2A : WE_2B); asm volatile("" : "+s"(ga_), "+s"(gb_)); pg8::Gemm g{ga_, gb_, M, DM, DFF}; pg8::StaticOrder S; S.init(M, DM, G, bx, F2_WGM);
                pg8::EpiResid<FP8_A1 != 0, true> E{HB, HLO, SS, HB8};
                pg8::gemm_phase<pg8::EpiResid<FP8_A1 != 0, true>, pg8::StaticOrder, true, true>(lds + RING_OFF, g, S, E, wave); }
#endif
            SEAM();
        } else {
            if (kind == 0) {
                for (int rep12_ = 0; rep12_ < DUP_A12; ++rep12_) { if (rep12_ > 0) { ph -= 2; }
#if EN_A1
#if FP8_A1
                for (int rep_ = 0; rep_ < DUP_A1; ++rep_) if (IN_PH()) { WSP_DECL;
                    { const bf16* ga_ = HB; const bf16* gb_ = WB + WE_MIX0; asm volatile("" : "+s"(ga_), "+s"(gb_));
                      pg8::Gemm g{ga_, gb_, M, 12288, DM}; pg8::StaticOrder S; S.init(M, 12288, G, bx);
                      RSTD_TABLE(32, SS, 32, 1.0f / 2048.0f);
                      pg8::EpiQKVA<1> E{QKV, rsl, cosA, sinA, 1.0f};
                      pg8::gemm_phase<pg8::EpiQKVA<1>, pg8::StaticOrder, true, true>(lds + RING_OFF, g, S, E, wave); }
                    { const bf16* ga_ = (const bf16*)HB8; const bf16* gb_ = WB + WE_AV8; asm volatile("" : "+s"(ga_), "+s"(gb_));
                      pg8::Gemm g{ga_, gb_, M, 6144, DM / 2}; pg8::StaticOrder S; S.init(M, 6144, G, bx);
                      RSTD_TABLE(32, SS, 32, 1.0f / 2048.0f);
                      pg8::EpiQKVA<2> E{QKV, rsl, cosA, sinA, 1.0f / 64.0f};
                      pg8::gemm_phase<pg8::EpiQKVA<2>, pg8::StaticOrder, true, true, true>(lds + RING_OFF, g, S, E, wave); }
                }
#else
                for (int rep_ = 0; rep_ < DUP_A1; ++rep_) if (IN_PH()) { WSP_DECL; const bf16* ga_ = HB; const bf16* gb_ = WB + WE_MIX0; asm volatile("" : "+s"(ga_), "+s"(gb_));
                    pg8::Gemm g{ga_, gb_, M, NQKV, DM}; pg8::StaticOrder S; S.init(M, NQKV, G, bx);
                    RSTD_TABLE(32, SS, 32, 1.0f / 2048.0f);
                    pg8::EpiQKVA<0> E{QKV, rsl, cosA, sinA, 1.0f};
                    pg8::gemm_phase<pg8::EpiQKVA<0>, pg8::StaticOrder, true, true>(lds + RING_OFF, g, S, E, wave); }
#endif
#endif
                SEAM();
#if EN_A2
                if (IN_PH()) { WSP_DECL;
                    att::Blk cur; att::Tens TT{nullptr, nullptr, nullptr, nullptr, nullptr, nullptr};
                    const int nblk = (3072 - bx + G - 1) / G;
#define ABLK(dst, Lx) do { const int L_ = (Lx); const int j_ = ((L_ & 31) + 3 * (L_ >> 8)) & 31, hd_ = (L_ >> 5) & 15,     \
        bg_ = L_ >> 9, g_ = bg_ % 3, b_ = bg_ / 3; const int dil_ = (g_ == 0) ? 1 : (g_ == 1 ? 4 : 16), nqb_ = 32 / dil_; \
        const int c_ = j_ / nqb_, qb_ = j_ - c_ * nqb_; const size_t t0_ = (size_t)b_ * SEQ + c_; dst.base = QKV + t0_ * NQKV + g_ * 6144 + hd_ * 128; dst.ld = dil_ * NQKV; \
        dst.P0 = qb_ * 256; dst.ldl = dil_ * 16; dst.lse = LSE + (size_t)g_ * M * 16 + t0_ * 16 + hd_; dst.row0 = 0; dst.hd = 0; } while (0)
                    att::Blk nxt; att::PF pf; ABLK(cur, bx); att::pf_request<att::CfgA>(pf, cur, TT, 129, wave);
                    for (int i = 0; i < nblk; ++i) {
                        const bool hn = (i + 1 < nblk); if (hn) { ABLK(nxt, bx + (i + 1) * G); } else nxt = cur;
                        const int g_ = ((bx + i * G) >> 9) % 3; const int skv = (g_ == 0) ? 8192 : (g_ == 1 ? 2048 : 512);
                        att::attn_block_pf<att::CfgA>(cur, TT, skv, 129, (char*)lds_raw + RING_OFF, wave, pf, i > 0, nxt, 0, hn);
                        cur = nxt;
                    }
#undef ABLK
                }
#endif
                SEAM();
                }
#if EN_A3
                for (int rep_ = 0; rep_ < DUP_EW; ++rep_) if (IN_PH()) { WSP_DECL; int lane_ = LANE(); asm volatile("" : "+v"(lane_));
                    for (int m = gw; m < M; m += NGW) {
#pragma unroll
                        for (int j = 0; j < 4; ++j) { const int col = (j * 64 + lane_) * 8, hd = col >> 7;
                            const float l0 = LSE[(size_t)m * 16 + hd], l1 = LSE[(size_t)(M + m) * 16 + hd], l2 = LSE[(size_t)(2 * M + m) * 16 + hd];
                            const float mx = fmaxf(l0, fmaxf(l1, l2)); const float e0 = __expf(l0 - mx), e1 = __expf(l1 - mx), e2 = __expf(l2 - mx); const float inv = 1.0f / (e0 + e1 + e2);
                            const v4u a = *(const v4u*)(QKV + (size_t)m * NQKV + col), b = *(const v4u*)(QKV + (size_t)m * NQKV + 6144 + col), c = *(const v4u*)(QKV + (size_t)m * NQKV + 12288 + col);
                            v4u o;
#pragma unroll
                            for (int k = 0; k < 4; ++k) { const float alo = __uint_as_float(a[k] << 16), ahi = __uint_as_float(a[k] & 0xffff0000u), blo = __uint_as_float(b[k] << 16), bhi = __uint_as_float(b[k] & 0xffff0000u),
                                    clo = __uint_as_float(c[k] << 16), chi = __uint_as_float(c[k] & 0xffff0000u);
                                o[k] = pk2((alo * e0 + blo * e1 + clo * e2) * inv, (ahi * e0 + bhi * e1 + chi * e2) * inv); }
                            *(v4u*)(OC + (size_t)m * DM + col) = o; }
                    }
                }
#endif
                SEAM();
            } else if (kind == 1) {
#if EN_B1
                for (int rep_ = 0; rep_ < DUP_SMALLG; ++rep_) if (IN_PH()) { WSP_DECL; const bf16* ga_ = HB; const bf16* gb_ = WB + WE_MIX0; asm volatile("" : "+s"(ga_), "+s"(gb_)); pg8::Gemm g{ga_, gb_, M, BIN_PAD, DM}; pg8::StaticOrder S; S.init(M, BIN_PAD, G, bx);
                    pg8::EpiBin E{CQ, CKV, KR, SSQ, SSKV, SS, cosB, sinB};
                    pg8::gemm_phase<pg8::EpiBin, pg8::StaticOrder, true, true>(lds + RING_OFF, g, S, E, wave); }
#endif
                SEAM();
#if EN_B23
                for (int rep_ = 0; rep_ < DUP_SMALLG; ++rep_) if (IN_PH()) { WSP_DECL;
                    { const bf16* ga_ = CQ; const bf16* gb_ = WB + WE_MIX1; asm volatile("" : "+s"(ga_), "+s"(gb_)); pg8::Gemm g{ga_, gb_, M, 3072, BQ}; pg8::StaticOrder S; S.init(M, 3072, G, bx);
                      RSTD_TABLE(24, SSQ, 32, 1.0f / 1536.0f);
                      pg8::EpiUQ E{QN, QRo, rsl, cosB, sinB};
                      pg8::gemm_phase<pg8::EpiUQ, pg8::StaticOrder, true, true>(lds + RING_OFF, g, S, E, wave); }
                    { const bf16* ga_ = CKV; const bf16* gb_ = WB + WE_MIX2; asm volatile("" : "+s"(ga_), "+s"(gb_)); pg8::Gemm g{ga_, gb_, M, 4096, BKV}; pg8::StaticOrder S; S.init(M, 4096, G, bx);
                      RSTD_TABLE(8, SSKV, 8, 1.0f / 512.0f);
                      pg8::EpiUKV E{KN, VB, rsl};
                      pg8::gemm_phase<pg8::EpiUKV, pg8::StaticOrder, true, true>(lds + RING_OFF, g, S, E, wave); }
                }
#endif
                SEAM();
#if EN_B4
                for (int rep_ = 0; rep_ < DUP_B4; ++rep_) if (IN_PH()) { WSP_DECL;
                    att::Blk cur; att::Tens TT{QN, QRo, KN, KR, VB, OC};
                    const int nitem = (512 - bx + G - 1) / G, nblk = 2 * nitem;
#define BBLK(dst, ix) do { const int it_ = bx + ((ix) >> 1) * G, ps_ = (ix) & 1; const int bh_ = it_ >> 4, x_ = it_ & 15, qb_ = ps_ ? 31 - x_ : x_; \
        dst.row0 = (bh_ >> 4) * SEQ; dst.hd = bh_ & 15; dst.P0 = qb_ * 256; dst.base = nullptr; dst.lse = nullptr; dst.ld = 2048; dst.ldl = 0; } while (0)
                    for (int i = 0; i < nblk; ++i) {
                        BBLK(cur, i);
                        att::attn_block<att::CfgB>(cur, TT, SEQ, 1 << 30, (char*)lds_raw + RING_OFF, wave);
                    }
#undef BBLK
                }
#endif
                SEAM();
            } else {
#if EN_C1
                for (int rep_ = 0; rep_ < DUP_SMALLG; ++rep_) if (IN_PH()) { WSP_DECL; const bf16* ga_ = HB; const bf16* gb_ = WB + WE_MIX0; asm volatile("" : "+s"(ga_), "+s"(gb_)); pg8::Gemm g{ga_, gb_, M, 3 * DM, DM}; pg8::StaticOrder S; S.init(M, 3 * DM, G, bx);
                    RSTD_TABLE(32, SS, 32, 1.0f / 2048.0f);
                    pg8::EpiCin E{CU, BGt, rsl};
                    pg8::gemm_phase<pg8::EpiCin, pg8::StaticOrder, true, true>(lds + RING_OFF, g, S, E, wave); }
#endif
                SEAM();
#if EN_C2
                for (int rep_ = 0; rep_ < DUP_EW; ++rep_) if (IN_PH()) { WSP_DECL; const float* cw = args.in[layer_base(L) + 5]; int lane_ = LANE(); asm volatile("" : "+v"(lane_));
                    for (int m = gw; m < M; m += NGW) { const int t = m & (SEQ - 1);
#pragma unroll
                        for (int j = 0; j < 4; ++j) { const int col = (j * 64 + lane_) * 8;
                            const v4u x2 = *(const v4u*)(CU + (size_t)m * DM + col); v4u x1 = {0u, 0u, 0u, 0u}, x0 = {0u, 0u, 0u, 0u};
                            if (t >= 1) x1 = *(const v4u*)(CU + (size_t)(m - 1) * DM + col);
                            if (t >= 2) x0 = *(const v4u*)(CU + (size_t)(m - 2) * DM + col);
                            const v4u bg = *(const v4u*)(BGt + (size_t)m * DM + col);
                            const f32x4 w0a = *(const f32x4*)(cw + col), w0b = *(const f32x4*)(cw + col + 4), w1a = *(const f32x4*)(cw + DM + col), w1b = *(const f32x4*)(cw + DM + col + 4),
                                        w2a = *(const f32x4*)(cw + 2 * DM + col), w2b = *(const f32x4*)(cw + 2 * DM + col + 4);
                            v4u o;
#pragma unroll
                            for (int k = 0; k < 4; ++k) { const float wl0 = (k < 2) ? w0a[2 * k] : w0b[2 * k - 4], wh0 = (k < 2) ? w0a[2 * k + 1] : w0b[2 * k - 3];
                                const float wl1 = (k < 2) ? w1a[2 * k] : w1b[2 * k - 4], wh1 = (k < 2) ? w1a[2 * k + 1] : w1b[2 * k - 3];
                                const float wl2 = (k < 2) ? w2a[2 * k] : w2b[2 * k - 4], wh2 = (k < 2) ? w2a[2 * k + 1] : w2b[2 * k - 3];
                                const float zl = wl0 * __uint_as_float(x0[k] << 16) + wl1 * __uint_as_float(x1[k] << 16) + wl2 * __uint_as_float(x2[k] << 16);
                                const float zh = wh0 * __uint_as_float(x0[k] & 0xffff0000u) + wh1 * __uint_as_float(x1[k] & 0xffff0000u) + wh2 * __uint_as_float(x2[k] & 0xffff0000u);
                                o[k] = pk2(zl * __uint_as_float(bg[k] << 16), zh * __uint_as_float(bg[k] & 0xffff0000u)); }
                            *(v4u*)(OC + (size_t)m * DM + col) = o; }
                    }
                }
#endif
                SEAM();
            }
#if EN_OUT
            if (IN_PH()) { WSP_DECL; const bf16* ga_ = OC; const bf16* gb_ = WB + ((kind == 1) ? WE_MIX3 : WE_MIX1); asm volatile("" : "+s"(ga_), "+s"(gb_)); pg8::Gemm g{ga_, gb_, M, DM, DM}; pg8::StaticOrder S; S.init(M, DM, G, bx, F2_WGM);
                pg8::EpiResid<false, false> E{HB, HLO, SS, nullptr};
                pg8::gemm_phase<pg8::EpiResid<false, false>, pg8::StaticOrder, true, true>(lds + RING_OFF, g, S, E, wave); }
#endif
            SEAM();
        }
    }
    if (IN_PH()) { WSP_DECL; const float* gn = args.in[43]; const int lane = LANE();
        for (int m = gw; m < M; m += NGW) {
            float s = (lane < 32) ? SS[(size_t)m * 32 + lane] : 0.f; s = wave_sum(s);
            const float rs = 1.0f / sqrtf(s * (1.0f / 2048.0f) + 1e-6f);
            const unsigned long long* hr = (const unsigned long long*)(HB + (size_t)m * DM) + lane; const unsigned long long* lr = (const unsigned long long*)(HLO + (size_t)m * DM) + lane;
            f32x4* orow = (f32x4*)(args.out + (size_t)m * DM) + lane; const f32x4* gr = (const f32x4*)gn + lane;
#pragma unroll
            for (int j = 0; j < 8; ++j) { const unsigned long long a = (RES_MODE == 2) ? lr[64 * j] : hr[64 * j], b = (RES_MODE == 0) ? lr[64 * j] : 0ull; const unsigned a0 = (unsigned)a, a1 = (unsigned)(a >> 32), b0 = (unsigned)b, b1 = (unsigned)(b >> 32);
                const f32x4 h = (RES_MODE == 2) ? (f32x4){pg8::h_lo(a0), pg8::h_hi(a0), pg8::h_lo(a1), pg8::h_hi(a1)} : (f32x4){__uint_as_float(a0 << 16) + __uint_as_float(b0 << 16), __uint_as_float(a0 & 0xffff0000u) + __uint_as_float(b0 & 0xffff0000u), __uint_as_float(a1 << 16) + __uint_as_float(b1 << 16), __uint_as_float(a1 & 0xffff0000u) + __uint_as_float(b1 & 0xffff0000u)};
                orow[64 * j] = h * rs * gr[64 * j]; }
        }
    }
#if CLK_PROBE == 2
    if (tid == 0) atomicAdd(ctl + 2048, MISC[20]);
    xcd_barrier(bar, T0);
    if (bx == 0 && tid == 0) MISC[19] = __hip_atomic_load(ctl + 2048, __ATOMIC_RELAXED, __HIP_MEMORY_SCOPE_AGENT) / (unsigned)G / 100u;
    __syncthreads();
#endif
#if CLK_PROBE
    if (bx == 0 && tid == 0) { const unsigned mhz = MISC[19]; const unsigned long long t0 = __builtin_amdgcn_s_memrealtime(); while (__builtin_amdgcn_s_memrealtime() - t0 < (unsigned long long)mhz * 100ull) __builtin_amdgcn_s_sleep(32); }
#endif
#undef IN_PH
#undef SEAM
}

constexpr int N_PHASES = 36;
extern "C" void kernel_launch(void* const* d_in, const int* in_sizes, int n_in, void* d_out, int out_size, void* d_ws, size_t ws_size, hipStream_t stream) {
    static int grid = 0;
    if (grid == 0) {
        if (n_in != 44 || in_sizes[0] != M * DM || out_size != M * DM || ws_size < WS_END) { fprintf(stderr, "kernel_launch: unexpected shapes (n_in %d, in0 %d, out %d, ws %zu); nothing launched\n", n_in, n_in > 0 ? in_sizes[0] : -1, out_size, ws_size); grid = -1; return; }
        int dev = 0, cus = 0, per_cu = 0;
        if (hipGetDevice(&dev) != hipSuccess || hipDeviceGetAttribute(&cus, hipDeviceAttributeMultiprocessorCount, dev) != hipSuccess) { grid = -1; return; }
        if (hipFuncSetAttribute((const void*)mk_fwd, hipFuncAttributeMaxDynamicSharedMemorySize, LDS_BYTES) != hipSuccess) { fprintf(stderr, "kernel_launch: hipFuncSetAttribute failed\n"); grid = -1; return; }
        if (hipOccupancyMaxActiveBlocksPerMultiprocessor(&per_cu, (const void*)mk_fwd, NWAVES * 64, LDS_BYTES) != hipSuccess || per_cu < 1) fprintf(stderr, "kernel_launch: occupancy query reports %d\n", per_cu);
        (void)hipGetLastError();
        grid = cus;
    }
    if (grid < 0) return;
    if (hipMemsetAsync((char*)d_ws + WS_CTL, 0, CTL_ZERO_BYTES, stream) != hipSuccess) return;
    Args a{};
    for (int i = 0; i < 44; ++i) a.in[i] = (const float*)d_in[i];
    a.out = (float*)d_out; a.ws = (unsigned char*)d_ws;
    for (int i = 0; i < 16; ++i) a.invA[i] = (float)pow(500000.0, -(double)i / 16.0);
    for (int i = 0; i < 32; ++i) a.invB[i] = (float)pow(500000.0, -(double)i / 32.0);
#if MK_PER_PHASE
    for (int p = 0; p < N_PHASES; ++p) { a.ph_lo = p; a.ph_hi = p + 1; a.use_bar = 0; a.pad = 0;
        hipLaunchKernelGGL(mk_fwd, dim3(grid), dim3(NWAVES * 64), LDS_BYTES, stream, a); }
#else
    a.ph_lo = 0; a.ph_hi = N_PHASES; a.use_bar = 1; a.pad = 0;
    hipLaunchKernelGGL(mk_fwd, dim3(grid), dim3(NWAVES * 64), LDS_BYTES, stream, a);
#endif
}
```

```cpp
#include <hip/hip_runtime.h>
#include <cstdio>
#include <cstdint>
#include <cmath>
#define RES_MODE 1
#define SKIPW_ON 1
__device__ __forceinline__ int hw_lane() { int l; asm volatile("v_mbcnt_lo_u32_b32 %0, -1, 0\n\tv_mbcnt_hi_u32_b32 %0, -1, %0" : "=v"(l)); return l; }
namespace pg8 {
#define PG8_LAS __attribute__((address_space(3)))
typedef unsigned short bf16_t;
typedef short bf16x8 __attribute__((ext_vector_type(8)));
typedef float f32x4 __attribute__((ext_vector_type(4)));
typedef unsigned u32x4 __attribute__((ext_vector_type(4)));
typedef int i32x4 __attribute__((ext_vector_type(4)));
typedef unsigned u32x2 __attribute__((ext_vector_type(2)));
constexpr int BM = 256, BK = 64, HALF = 128, HTB = HALF * BK * 2  , STAGE_BYTES = 8 * HTB, NXCD = 8, WGM = 8;

__host__ __device__ __forceinline__ int lds_byte(int r, int c) { const int st = (r >> 4) * 2 + (c >> 5), rr = r & 15, cc = c & 31, ob = rr * 64 + cc * 2; return st * 1024 + (ob ^ (((ob >> 9) & 1) << 5)); }
__host__ __device__ __forceinline__ void stage_rc(int b, int& R, int& C) { const int st = b / 1024, sb = b % 1024, swz = sb ^ (((sb >> 9) & 1) << 5); R = (st >> 1) * 16 + swz / 64; C = (st & 1) * 32 + (swz % 64) / 2; }
__host__ __device__ __forceinline__ int perm32(int rho) { const int n = rho >> 4, i = rho & 15; return 8 * (i >> 2) + 4 * n + (i & 3); }

struct Unit { int pm, pn; };
struct Gemm { const bf16_t* A; const bf16_t* Bt; int M, N, K; };

struct StaticOrder {
    int nM, nN, nwg, G, c, wgm;
    __host__ __device__ __forceinline__ void init(int M, int N, int G_, int c_, int wgm_ = WGM) { nM = M / BM; nN = N / BM; nwg = nM * nN; G = G_; c = c_; wgm = wgm_; }
    __host__ __device__ __forceinline__ bool next(int i, Unit& u) const {
        const long L = (long)i * G + c; if (L >= nwg) return false;
        int wgid = (int)L; { const int q = nwg / NXCD, r = nwg % NXCD, xcd = wgid % NXCD, off = wgid / NXCD; wgid = (xcd < r ? xcd * (q + 1) : r * (q + 1) + (xcd - r) * q) + off; }
        const int nig = wgm * nN, gid = wgid / nig, fm = gid * wgm, gsz = (nM - fm) < wgm ? (nM - fm) : wgm;
        u.pm = fm + ((wgid % nig) % gsz); u.pn = (wgid % nig) / gsz; return true;
    }
    __device__ __forceinline__ void a_ready(const Unit&) const {}
    __device__ __forceinline__ void done(const Unit&) const {}
};
__device__ __forceinline__ unsigned cvt_pk_bf16(float lo, float hi) { unsigned r; asm volatile("v_cvt_pk_bf16_f32 %0, %1, %2" : "=v"(r) : "v"(lo), "v"(hi)); return r; }
typedef float f32x2e __attribute__((ext_vector_type(2)));
constexpr float NORM_EPS = 1e-6f;
template <int NPF> __device__ __forceinline__ float row_rstd(const float* SS, int row, int stride, int fq, float inv_n) {
    const float* p = SS + (size_t)row * stride + fq * NPF; float s;
    if constexpr (NPF == 8) { const f32x4 a = *(const f32x4*)p, b = *(const f32x4*)(p + 4); s = ((a[0] + a[1]) + (a[2] + a[3])) + ((b[0] + b[1]) + (b[2] + b[3])); }
    else if constexpr (NPF == 6) { const f32x2e a = *(const f32x2e*)p, b = *(const f32x2e*)(p + 2), c = *(const f32x2e*)(p + 4); s = (a[0] + a[1]) + (b[0] + b[1]) + (c[0] + c[1]); }
    else { const f32x2e a = *(const f32x2e*)p; s = a[0] + a[1]; }
    s += __shfl_xor(s, 16); s += __shfl_xor(s, 32);
    return 1.0f / sqrtf(s * inv_n + NORM_EPS);
}
template <int NPF> __device__ __forceinline__ void rstd8(const float* SS, int row0, int stride, int fq, float inv_n, float (&rs)[8]) {
    f32x2e v[8][NPF / 2];
#pragma unroll
    for (int i = 0; i < 8; ++i) { const float* p = SS + (size_t)(row0 + (i >> 2) * HALF + (i & 3) * 16) * stride + fq * NPF;
#pragma unroll
        for (int k = 0; k < NPF / 2; ++k) v[i][k] = *(const f32x2e*)(p + 2 * k); }
#pragma unroll
    for (int i = 0; i < 8; ++i) { float s = 0.f;
#pragma unroll
        for (int k = 0; k < NPF / 2; ++k) s += v[i][k][0] + v[i][k][1];
        s += __shfl_xor(s, 16); s += __shfl_xor(s, 32);
        rs[i] = 1.0f / sqrtf(s * inv_n + NORM_EPS); }
}
__device__ __forceinline__ u32x4 pack8bf(const f32x4 v0, const f32x4 v1) { u32x4 w; w.x = cvt_pk_bf16(v0[0], v0[1]); w.y = cvt_pk_bf16(v0[2], v0[3]); w.z = cvt_pk_bf16(v1[0], v1[1]); w.w = cvt_pk_bf16(v1[2], v1[3]); return w; }
__device__ __forceinline__ u32x2 pack8f8(const f32x4 v0, const f32x4 v1) { unsigned lo = 0, hi = 0;
    lo = __builtin_amdgcn_cvt_pk_fp8_f32(v0[0], v0[1], lo, false); lo = __builtin_amdgcn_cvt_pk_fp8_f32(v0[2], v0[3], lo, true);
    hi = __builtin_amdgcn_cvt_pk_fp8_f32(v1[0], v1[1], hi, false); hi = __builtin_amdgcn_cvt_pk_fp8_f32(v1[2], v1[3], hi, true);
    return (u32x2){lo, hi}; }
typedef _Float16 h16x2 __attribute__((ext_vector_type(2)));
__device__ __forceinline__ unsigned pkh2(float lo, float hi) { const h16x2 p = {(_Float16)lo, (_Float16)hi}; return __builtin_bit_cast(unsigned, p); }
__device__ __forceinline__ u32x4 pack8h(const f32x4 v0, const f32x4 v1) { u32x4 w; w.x = pkh2(v0[0], v0[1]); w.y = pkh2(v0[2], v0[3]); w.z = pkh2(v1[0], v1[1]); w.w = pkh2(v1[2], v1[3]); return w; }
__device__ __forceinline__ float h_lo(unsigned w) { return (float)__builtin_bit_cast(h16x2, w)[0]; }
__device__ __forceinline__ float h_hi(unsigned w) { return (float)__builtin_bit_cast(h16x2, w)[1]; }
__device__ __forceinline__ float dot4(const f32x4 a) { return (a[0] * a[0] + a[1] * a[1]) + (a[2] * a[2] + a[3] * a[3]); }
__device__ __forceinline__ f32x4 silu_mul(const f32x4 g, const f32x4 u) { f32x4 o;
#pragma unroll
    for (int j = 0; j < 4; ++j) { const float e = __builtin_amdgcn_exp2f(g[j] * -1.4426950408889634f); o[j] = g[j] * __builtin_amdgcn_rcpf(1.0f + e) * u[j]; }
    return o; }
__device__ __forceinline__ f32x4 silu_mul_rs(const f32x4 g, const f32x4 u, const float k, const float rs2, const f32x4 one) {
    const f32x4 ea = g * k; f32x4 e;
#pragma unroll
    for (int j = 0; j < 4; ++j) e[j] = __builtin_amdgcn_exp2f(ea[j]);
    const f32x4 d = e + one; f32x4 r;
#pragma unroll
    for (int j = 0; j < 4; ++j) r[j] = __builtin_amdgcn_rcpf(d[j]);
    return (g * u) * (r * rs2); }

struct EpiSwiGLU {
    static constexpr bool PERM = true, AFTER_DRAIN = false, HAS_INIT = false;
    bf16_t* O; int ldc; const PG8_LAS float* rsl;
    __device__ __forceinline__ void operator()(const f32x4 (&acc)[2][2][4][2], const Unit& u, int wr, int wc, int fr, int fq) const {
        const int row0 = u.pm * BM + wr * 64 + fr, col0 = u.pn * HALF + wc * 32 + 8 * fq;
        const __amdgpu_buffer_rsrc_t rsrc = __builtin_amdgcn_make_buffer_rsrc(O, 0, 0x7fffffff, 0x00020000);
        float one1 = 1.0f; asm volatile("" : "+v"(one1)); const f32x4 one = {one1, one1, one1, one1};
#pragma unroll
        for (int ai = 0; ai < 2; ++ai)
#pragma unroll
            for (int m = 0; m < 4; ++m) { const int row = row0 + ai * HALF + m * 16; const float rs = rsl[ai * HALF + wr * 64 + m * 16 + fr];
                const float kk = rs * -1.4426950408889634f, rs2 = rs * rs;
                const f32x4 y0 = silu_mul_rs(acc[ai][0][m][0], acc[ai][1][m][0], kk, rs2, one), y1 = silu_mul_rs(acc[ai][0][m][1], acc[ai][1][m][1], kk, rs2, one);
                __builtin_amdgcn_raw_buffer_store_b128(pack8bf(y0, y1), rsrc, (int)(((unsigned)row * (unsigned)ldc + (unsigned)col0) * 2u), 0, 16);     }
    }
};
#ifndef RES_MODE
#define RES_MODE 0
#endif
template <bool W8, bool HALFSTEP> struct EpiResid {
    static constexpr bool PERM = true, AFTER_DRAIN = false, HAS_INIT = true;
    static constexpr float alpha = HALFSTEP ? 0.5f : 1.0f, inv_alpha = HALFSTEP ? 2.0f : 1.0f;
    bf16_t* hb; bf16_t* lo; float* SSo; unsigned char* hb8;
    __device__ __forceinline__ void init(f32x4 (&acc)[2][2][4][2], const Unit& u, int wr, int wc, int fr, int fq) const {
        const int row0 = u.pm * BM + wr * 64 + fr, col0 = u.pn * BM + wc * 32 + 8 * fq;
#pragma unroll
        for (int ai = 0; ai < 2; ++ai)
#pragma unroll
            for (int m = 0; m < 4; ++m)
#pragma unroll
                for (int bj = 0; bj < 2; ++bj) { const size_t off = (size_t)(row0 + ai * HALF + m * 16) * 2048 + col0 + bj * HALF; f32x4 x0, x1;
                    if constexpr (RES_MODE == 2) { const u32x4 a = *(const u32x4*)(lo + off); x0 = (f32x4){h_lo(a[0]), h_hi(a[0]), h_lo(a[1]), h_hi(a[1])}; x1 = (f32x4){h_lo(a[2]), h_hi(a[2]), h_lo(a[3]), h_hi(a[3])}; }
                    else { const u32x4 a = *(const u32x4*)(hb + off);
                        x0 = (f32x4){__uint_as_float(a[0] << 16), __uint_as_float(a[0] & 0xffff0000u), __uint_as_float(a[1] << 16), __uint_as_float(a[1] & 0xffff0000u)};
                        x1 = (f32x4){__uint_as_float(a[2] << 16), __uint_as_float(a[2] & 0xffff0000u), __uint_as_float(a[3] << 16), __uint_as_float(a[3] & 0xffff0000u)};
                        if constexpr (RES_MODE == 0) { const u32x4 b = *(const u32x4*)(lo + off);
                            x0 += (f32x4){__uint_as_float(b[0] << 16), __uint_as_float(b[0] & 0xffff0000u), __uint_as_float(b[1] << 16), __uint_as_float(b[1] & 0xffff0000u)};
                            x1 += (f32x4){__uint_as_float(b[2] << 16), __uint_as_float(b[2] & 0xffff0000u), __uint_as_float(b[3] << 16), __uint_as_float(b[3] & 0xffff0000u)}; } }
                    acc[ai][bj][m][0] = x0 * inv_alpha; acc[ai][bj][m][1] = x1 * inv_alpha; }
    }
    __device__ __forceinline__ void operator()(const f32x4 (&acc)[2][2][4][2], const Unit& u, int wr, int wc, int fr, int fq) const {
        const int row0 = u.pm * BM + wr * 64 + fr, col0 = u.pn * BM + wc * 32 + 8 * fq;
#pragma unroll
        for (int ai = 0; ai < 2; ++ai)
#pragma unroll
            for (int m = 0; m < 4; ++m) { const int row = row0 + ai * HALF + m * 16; float s = 0.f;
#pragma unroll
                for (int bj = 0; bj < 2; ++bj) { const size_t off = (size_t)row * 2048 + col0 + bj * HALF;
                    const f32x4 h0 = acc[ai][bj][m][0] * alpha, h1 = acc[ai][bj][m][1] * alpha;
                    const u32x4 w = pack8bf(h0, h1);
                    *(u32x4*)(hb + off) = w;
                    if constexpr (RES_MODE == 0) {
                        const f32x4 r0 = {h0[0] - __uint_as_float(w[0] << 16), h0[1] - __uint_as_float(w[0] & 0xffff0000u), h0[2] - __uint_as_float(w[1] << 16), h0[3] - __uint_as_float(w[1] & 0xffff0000u)};
                        const f32x4 r1 = {h1[0] - __uint_as_float(w[2] << 16), h1[1] - __uint_as_float(w[2] & 0xffff0000u), h1[2] - __uint_as_float(w[3] << 16), h1[3] - __uint_as_float(w[3] & 0xffff0000u)};
                        *(u32x4*)(lo + off) = pack8bf(r0, r1); }
                    if constexpr (RES_MODE == 2) *(u32x4*)(lo + off) = pack8h(h0, h1);
                    if constexpr (W8) *(u32x2*)(hb8 + off) = pack8f8(h0, h1);
                    s += dot4(h0) + dot4(h1); }
                s += __shfl_xor(s, 16); s += __shfl_xor(s, 32);
                if (fq == 0) SSo[(size_t)row * 32 + u.pn * 4 + wc] = s; }
    }
};
template <int MODE  > struct EpiQKVA {
    static constexpr bool PERM = true, AFTER_DRAIN = false, HAS_INIT = false;
    bf16_t* O; const PG8_LAS float* rsl; const float* cosT; const float* sinT; float wscale;
    __device__ __forceinline__ void operator()(const f32x4 (&acc)[2][2][4][2], const Unit& u, int wr, int wc, int fr, int fq) const {
        const int ot = (MODE == 0) ? u.pn : (MODE == 1 ? (u.pn >> 4) * 24 + (u.pn & 15) : (u.pn >> 3) * 24 + 16 + (u.pn & 7));
        const int row0 = u.pm * BM + wr * 64 + fr, col0 = ot * BM + wc * 32 + 8 * fq;
        const int t = (ot >> 3) % 3; const bool rope = (MODE != 2) && (t != 2) && (wc == 0);
        f32x4 cs[8], sn[8];
        if (rope) {
#pragma unroll
            for (int i = 0; i < 8; ++i) { const size_t ro = (size_t)(row0 + (i >> 2) * HALF + (i & 3) * 16) * 16 + 4 * fq; cs[i] = *(const f32x4*)(cosT + ro); sn[i] = *(const f32x4*)(sinT + ro); }
        } else {
#pragma unroll
            for (int i = 0; i < 8; ++i) { cs[i] = (f32x4){1.f, 1.f, 1.f, 1.f}; sn[i] = (f32x4){0.f, 0.f, 0.f, 0.f}; }
        }
        asm volatile("" ::: "memory");
#pragma unroll
        for (int ai = 0; ai < 2; ++ai)
#pragma unroll
            for (int m = 0; m < 4; ++m) { const int row = row0 + ai * HALF + m * 16; const float rs = rsl[ai * HALF + wr * 64 + m * 16 + fr] * wscale;
                const f32x4 c = cs[ai * 4 + m], s = sn[ai * 4 + m];
#pragma unroll
                for (int bj = 0; bj < 2; ++bj) { f32x4 v0 = acc[ai][bj][m][0] * rs, v1 = acc[ai][bj][m][1] * rs;
                    if (rope) { const f32x4 o0 = v0 * c - v1 * s, o1 = v1 * c + v0 * s; v0 = o0; v1 = o1; }
                    *(u32x4*)(O + (size_t)row * 18432 + col0 + bj * HALF) = pack8bf(v0, v1); } }
    }
};
struct EpiBin {
    static constexpr bool PERM = true, AFTER_DRAIN = false, HAS_INIT = false;
    bf16_t* CQ; bf16_t* CKV; bf16_t* KR; float* SSQ; float* SSKV; const float* SS; const float* cosT; const float* sinT;
    __device__ __forceinline__ void operator()(const f32x4 (&acc)[2][2][4][2], const Unit& u, int wr, int wc, int fr, int fq) const {
        const int row0 = u.pm * BM + wr * 64 + fr; const int pn = u.pn;
#pragma unroll
        for (int ai = 0; ai < 2; ++ai)
#pragma unroll
            for (int m = 0; m < 4; ++m) { const int row = row0 + ai * HALF + m * 16; const float rs = row_rstd<8>(SS, row, 32, fq, 1.0f / 2048.0f);
                if (pn < 8) {
                    bf16_t* dst; float* ssd;
                    if (pn < 6) { dst = CQ + (size_t)row * 1536 + pn * BM; ssd = SSQ + (size_t)row * 32 + pn * 4 + wc; }
                    else { dst = CKV + (size_t)row * 512 + (pn - 6) * BM; ssd = SSKV + (size_t)row * 8 + (pn - 6) * 4 + wc; }
                    float s = 0.f;
#pragma unroll
                    for (int bj = 0; bj < 2; ++bj) { const f32x4 v0 = acc[ai][bj][m][0] * rs, v1 = acc[ai][bj][m][1] * rs; s += dot4(v0) + dot4(v1);
                        *(u32x4*)(dst + bj * HALF + wc * 32 + 8 * fq) = pack8bf(v0, v1); }
                    s += __shfl_xor(s, 16); s += __shfl_xor(s, 32);
                    if (fq == 0) *ssd = s;
                } else if (wc == 0) {
                    const f32x4 x1a = acc[ai][0][m][0] * rs, x1b = acc[ai][0][m][1] * rs, x2a = acc[ai][1][m][0] * rs, x2b = acc[ai][1][m][1] * rs;
                    const float* cp = cosT + (size_t)row * 32 + 8 * fq; const float* sp = sinT + (size_t)row * 32 + 8 * fq;
                    const f32x4 c0 = *(const f32x4*)cp, c1 = *(const f32x4*)(cp + 4), s0 = *(const f32x4*)sp, s1 = *(const f32x4*)(sp + 4);
                    *(u32x4*)(KR + (size_t)row * 64 + 8 * fq) = pack8bf(x1a * c0 - x2a * s0, x1b * c1 - x2b * s1);
                    *(u32x4*)(KR + (size_t)row * 64 + 32 + 8 * fq) = pack8bf(x2a * c0 + x1a * s0, x2b * c1 + x1b * s1);
                } asm volatile("" ::: "memory"); }
    }
};
struct EpiUQ {
    static constexpr bool PERM = true, AFTER_DRAIN = false, HAS_INIT = false;
    bf16_t* QN; bf16_t* QRo; const PG8_LAS float* rsl; const float* cosT; const float* sinT;
    __device__ __forceinline__ void operator()(const f32x4 (&acc)[2][2][4][2], const Unit& u, int wr, int wc, int fr, int fq) const {
        const int row0 = u.pm * BM + wr * 64 + fr; const int pn = u.pn;
#pragma unroll
        for (int ai = 0; ai < 2; ++ai)
#pragma unroll
            for (int m = 0; m < 4; ++m) { const int row = row0 + ai * HALF + m * 16; const float rs = rsl[ai * HALF + wr * 64 + m * 16 + fr];
                if (pn < 8) {
#pragma unroll
                    for (int bj = 0; bj < 2; ++bj) *(u32x4*)(QN + (size_t)row * 2048 + pn * BM + bj * HALF + wc * 32 + 8 * fq) = pack8bf(acc[ai][bj][m][0] * rs, acc[ai][bj][m][1] * rs);
                } else {
                    const int head = (pn - 8) * 4 + wc;
                    const f32x4 x1a = acc[ai][0][m][0] * rs, x1b = acc[ai][0][m][1] * rs, x2a = acc[ai][1][m][0] * rs, x2b = acc[ai][1][m][1] * rs;
                    const float* cp = cosT + (size_t)row * 32 + 8 * fq; const float* sp = sinT + (size_t)row * 32 + 8 * fq;
                    const f32x4 c0 = *(const f32x4*)cp, c1 = *(const f32x4*)(cp + 4), s0 = *(const f32x4*)sp, s1 = *(const f32x4*)(sp + 4);
                    bf16_t* d = QRo + (size_t)row * 1024 + head * 64 + 8 * fq;
                    *(u32x4*)d = pack8bf(x1a * c0 - x2a * s0, x1b * c1 - x2b * s1);
                    *(u32x4*)(d + 32) = pack8bf(x2a * c0 + x1a * s0, x2b * c1 + x1b * s1);
                } asm volatile("" ::: "memory"); }
    }
};
struct EpiUKV {
    static constexpr bool PERM = true, AFTER_DRAIN = false, HAS_INIT = false;
    bf16_t* KN; bf16_t* VB; const PG8_LAS float* rsl;
    __device__ __forceinline__ void operator()(const f32x4 (&acc)[2][2][4][2], const Unit& u, int wr, int wc, int fr, int fq) const {
        const int row0 = u.pm * BM + wr * 64 + fr; const int col0 = u.pn * HALF + wc * 32 + 8 * fq;
#pragma unroll
        for (int ai = 0; ai < 2; ++ai)
#pragma unroll
            for (int m = 0; m < 4; ++m) { const int row = row0 + ai * HALF + m * 16; const float rs = rsl[ai * HALF + wr * 64 + m * 16 + fr];
                *(u32x4*)(KN + (size_t)row * 2048 + col0) = pack8bf(acc[ai][0][m][0] * rs, acc[ai][0][m][1] * rs);
                *(u32x4*)(VB + (size_t)row * 2048 + col0) = pack8bf(acc[ai][1][m][0] * rs, acc[ai][1][m][1] * rs); asm volatile("" ::: "memory"); }
    }
};
struct EpiCin {
    static constexpr bool PERM = true, AFTER_DRAIN = false, HAS_INIT = false;
    bf16_t* CU; bf16_t* BG; const PG8_LAS float* rsl;
    __device__ __forceinline__ void operator()(const f32x4 (&acc)[2][2][4][2], const Unit& u, int wr, int wc, int fr, int fq) const {
        const int row0 = u.pm * BM + wr * 64 + fr; const int pn = u.pn;
#pragma unroll
        for (int ai = 0; ai < 2; ++ai)
#pragma unroll
            for (int m = 0; m < 4; ++m) { const int row = row0 + ai * HALF + m * 16; const float rs = rsl[ai * HALF + wr * 64 + m * 16 + fr];
                if (pn < 16) { const float r2 = rs * rs;
                    *(u32x4*)(CU + (size_t)row * 2048 + pn * HALF + wc * 32 + 8 * fq) = pack8bf(acc[ai][0][m][0] * acc[ai][1][m][0] * r2, acc[ai][0][m][1] * acc[ai][1][m][1] * r2);
                } else {
#pragma unroll
                    for (int bj = 0; bj < 2; ++bj) *(u32x4*)(BG + (size_t)row * 2048 + (pn - 16) * BM + bj * HALF + wc * 32 + 8 * fq) = pack8bf(acc[ai][bj][m][0] * rs, acc[ai][bj][m][1] * rs);
                } asm volatile("" ::: "memory"); }
    }
};
typedef int i32x8 __attribute__((ext_vector_type(8)));
typedef _Float16 h16x8 __attribute__((ext_vector_type(8)));
template <class Epi, class Sched, bool ALIGN_EPI = false, bool SP2 = false, bool F8 = false, bool HF = false  >
__device__ __forceinline__ void gemm_phase(PG8_LAS unsigned char* lds, const Gemm g, const Sched& S, const Epi& E, const int wave_in) {
    int tid_ = wave_in * 64 + hw_lane(); asm volatile("" : "+v"(tid_));
    const int tid = tid_, wid = __builtin_amdgcn_readfirstlane(tid >> 6), lane = tid & 63, wr = wid >> 2, wc = wid & 3, fr = lane & 15, fq = lane >> 4;
    const int K = g.K, nt = K / BK;
    unsigned voffA[2], voffB[2];
#pragma unroll
    for (int i = 0; i < 2; ++i) { int R, C; stage_rc(tid * 16 + i * 8192, R, C); const int Rb = Epi::PERM ? ((R & ~31) + perm32(R & 31)) : R;
        voffA[i] = (unsigned)(R * K + C) * 2u; voffB[i] = (unsigned)(Rb * K + C) * 2u; }
    const size_t kstep = (size_t)(BK * 2);
    const size_t hstep = (size_t)HALF * K * 2;
    const size_t tstep = 2 * hstep;
    const unsigned ldsw = (unsigned)wid * 1024u;
    const int aoff = lds_byte(wr * 64 + fr, fq * 8), boff = lds_byte(wc * 32 + fr, fq * 8);
#define PG8_SA(b, h) (((b) * 2 + (h)) * HTB)
#define PG8_SB(b, h) ((4 + (b) * 2 + (h)) * HTB)
#define PG8_STAGE(bufoff, gbase, voff) do { _Pragma("unroll") for (int _i = 0; _i < 2; ++_i) \
        __builtin_amdgcn_global_load_lds((const unsigned*)((const char*)(gbase) + (voff)[_i]), (PG8_LAS unsigned*)(lds + (bufoff) + ldsw + _i * 8192), 16, 0, 0); } while (0)
#define PG8_LD1(off_) (*(const PG8_LAS i32x4*)(lds + (off_)))
#define PG8_LDA(dst, b, h) do { if constexpr (F8) { _Pragma("unroll") for (int m = 0; m < 4; ++m) dst##8[m] = __builtin_shufflevector(PG8_LD1(PG8_SA(b, h) + aoff + m * 2048), PG8_LD1(PG8_SA(b, h) + aoff + m * 2048 + 1024), 0, 1, 2, 3, 4, 5, 6, 7); } \
        else { _Pragma("unroll") for (int m = 0; m < 4; ++m) _Pragma("unroll") for (int k = 0; k < 2; ++k) dst[m][k] = *(const PG8_LAS bf16x8*)(lds + PG8_SA(b, h) + aoff + m * 2048 + k * 1024); } } while (0)
#define PG8_LDB(dst, b, h) do { if constexpr (F8) { _Pragma("unroll") for (int n = 0; n < 2; ++n) dst##8[n] = __builtin_shufflevector(PG8_LD1(PG8_SB(b, h) + boff + n * 2048), PG8_LD1(PG8_SB(b, h) + boff + n * 2048 + 1024), 0, 1, 2, 3, 4, 5, 6, 7); } \
        else { _Pragma("unroll") for (int n = 0; n < 2; ++n) _Pragma("unroll") for (int k = 0; k < 2; ++k) dst[n][k] = *(const PG8_LAS bf16x8*)(lds + PG8_SB(b, h) + boff + n * 2048 + k * 1024); } } while (0)
#define PG8_MMA(ai, bj, At, Bt) do { __builtin_amdgcn_s_setprio(1); \
        if constexpr (F8) { _Pragma("unroll") for (int m = 0; m < 4; ++m) _Pragma("unroll") for (int n = 0; n < 2; ++n) \
            asm volatile("v_mfma_scale_f32_16x16x128_f8f6f4 %0, %1, %2, %0, %3, %3 op_sel_hi:[0,0,0]" : "+v"(acc[ai][bj][m][n]) : "v"(Bt##8[n]), "v"(At##8[m]), "v"(sc7f)); } \
        else { _Pragma("unroll") for (int m = 0; m < 4; ++m) _Pragma("unroll") for (int n = 0; n < 2; ++n) _Pragma("unroll") for (int k = 0; k < 2; ++k) \
        acc[ai][bj][m][n] = HF ? __builtin_amdgcn_mfma_f32_16x16x32_f16(__builtin_bit_cast(h16x8, Bt[n][k]), __builtin_bit_cast(h16x8, At[m][k]), acc[ai][bj][m][n], 0, 0, 0) \
                                : __builtin_amdgcn_mfma_f32_16x16x32_bf16(Bt[n][k], At[m][k], acc[ai][bj][m][n], 0, 0, 0); } __builtin_amdgcn_s_setprio(0); } while (0)
#define PG8_WAIT_V(n) asm volatile("s_waitcnt vmcnt(" #n ")" ::: "memory")
#define PG8_WAIT_L(n) asm volatile("s_waitcnt lgkmcnt(" #n ")" ::: "memory")
#define PG8_BAR __builtin_amdgcn_s_barrier()
#define PG8_WAIT_V8_UNLESS(f) asm volatile("s_cmp_lg_u32 %0, 0\n\ts_cbranch_scc1 .Lpg8sk%=\n\ts_waitcnt vmcnt(8)\n.Lpg8sk%=:" :: "s"(f) : "scc", "memory")
#define PG8_SCHED __builtin_amdgcn_sched_barrier(0)
#ifndef SKIPW_ON
#define SKIPW_ON 0
#endif
    constexpr bool SKIPW = SKIPW_ON && !Epi::HAS_INIT;
    Unit cur, nxt; int ui = 0;
    if (!S.next(0, cur)) return;
    f32x4 acc[2][2][4][2];
    if constexpr (Epi::HAS_INIT) { E.init(acc, cur, wr, wc, fr, fq); } else {
#pragma unroll
    for (int a = 0; a < 2; ++a)
#pragma unroll
        for (int b = 0; b < 2; ++b)
#pragma unroll
            for (int m = 0; m < 4; ++m)
#pragma unroll
                for (int n = 0; n < 2; ++n) acc[a][b][m][n] = (f32x4){0.f, 0.f, 0.f, 0.f};
    }
    const int sc7f = 0x7F7F7F7F; (void)sc7f;
    bf16x8 At[4][2], B0[2][2], B1[2][2]; i32x8 At8[4], B08[2], B18[2]; (void)At; (void)B0; (void)B1; (void)At8; (void)B08; (void)B18;
    const char* cA = (const char*)g.A + (size_t)cur.pm * tstep; const char* cB = (const char*)g.Bt + (size_t)cur.pn * tstep;
    S.a_ready(cur);
    if constexpr (SP2) {
        PG8_STAGE(PG8_SB(0, 0), cB, voffB); PG8_STAGE(PG8_SB(0, 1), cB + hstep, voffB); PG8_STAGE(PG8_SA(0, 0), cA, voffA); PG8_STAGE(PG8_SA(0, 1), cA + hstep, voffA);
        if (wr == 1) PG8_BAR;
        PG8_WAIT_V(2); PG8_BAR;
        PG8_STAGE(PG8_SB(1, 0), cB + kstep, voffB); PG8_STAGE(PG8_SA(1, 0), cA + kstep, voffA); PG8_STAGE(PG8_SB(1, 1), cB + hstep + kstep, voffB);
        PG8_WAIT_V(6); PG8_BAR;
    } else {
        PG8_STAGE(PG8_SB(0, 0), cB, voffB); PG8_STAGE(PG8_SA(0, 0), cA, voffA); PG8_STAGE(PG8_SB(0, 1), cB + hstep, voffB); PG8_STAGE(PG8_SA(0, 1), cA + hstep, voffA);
        if (wr == 1) PG8_BAR;
        PG8_WAIT_V(4); PG8_BAR;
        PG8_STAGE(PG8_SB(1, 0), cB + kstep, voffB); PG8_STAGE(PG8_SA(1, 0), cA + kstep, voffA); PG8_STAGE(PG8_SB(1, 1), cB + hstep + kstep, voffB);
        PG8_WAIT_V(6); PG8_BAR;
    }
    for (;;) {
        const bool has_next = S.next(ui + 1, nxt);
        const char* nA = has_next ? (const char*)g.A + (size_t)nxt.pm * tstep : cA; const char* nB = has_next ? (const char*)g.Bt + (size_t)nxt.pn * tstep : cB;
        for (int t = 0; t < nt; t += 2) {
            const bool last = (t == nt - 2);
            const char* a1 = cA + (size_t)(t + 1) * kstep;
            const char* a2 = last ? nA : cA + (size_t)(t + 2) * kstep; const char* b2 = last ? nB : cB + (size_t)(t + 2) * kstep;
            const char* a3 = a2 + kstep; const char* b3 = b2 + kstep;
            if (last && has_next) S.a_ready(nxt);
            const int skipw_ = __builtin_amdgcn_readfirstlane((t == 0 && ui > 0) ? 1 : 0); (void)skipw_;
            if constexpr (SP2) {
            PG8_LDB(B0, 0, 0); PG8_LDB(B1, 0, 1); PG8_SCHED; PG8_LDA(At, 0, 0); PG8_STAGE(PG8_SA(1, 1), a1 + hstep, voffA);
            if constexpr (SKIPW) PG8_WAIT_V8_UNLESS(skipw_); else PG8_WAIT_V(8); PG8_WAIT_L(0); PG8_BAR; PG8_MMA(0, 0, At, B0); PG8_MMA(0, 1, At, B1); PG8_BAR; PG8_SCHED;
            PG8_LDA(At, 0, 1); PG8_STAGE(PG8_SB(0, 0), b2, voffB); PG8_STAGE(PG8_SB(0, 1), b2 + hstep, voffB); PG8_STAGE(PG8_SA(0, 0), a2, voffA);
            if constexpr (SKIPW) PG8_WAIT_V8_UNLESS(skipw_); else PG8_WAIT_V(8); PG8_WAIT_L(0); PG8_BAR; PG8_MMA(1, 0, At, B0); PG8_MMA(1, 1, At, B1); PG8_BAR; PG8_SCHED;
            PG8_LDB(B0, 1, 0); PG8_LDB(B1, 1, 1); PG8_SCHED; PG8_LDA(At, 1, 0); PG8_STAGE(PG8_SA(0, 1), a2 + hstep, voffA);
            PG8_WAIT_V(8); PG8_WAIT_L(0); PG8_BAR; PG8_MMA(0, 0, At, B0); PG8_MMA(0, 1, At, B1); PG8_BAR; PG8_SCHED;
            PG8_LDA(At, 1, 1); PG8_STAGE(PG8_SB(1, 0), b3, voffB); PG8_STAGE(PG8_SB(1, 1), b3 + hstep, voffB); PG8_STAGE(PG8_SA(1, 0), a3, voffA);
            PG8_WAIT_V(8); PG8_WAIT_L(0); PG8_BAR; PG8_MMA(1, 0, At, B0); PG8_MMA(1, 1, At, B1); PG8_BAR; PG8_SCHED;
            } else {
            PG8_LDB(B0, 0, 0); PG8_SCHED; PG8_LDA(At, 0, 0); PG8_STAGE(PG8_SA(1, 1), a1 + hstep, voffA);
            PG8_WAIT_L(8); PG8_BAR; PG8_WAIT_L(0); PG8_MMA(0, 0, At, B0); PG8_BAR; PG8_SCHED;
            PG8_LDB(B1, 0, 1); PG8_STAGE(PG8_SB(0, 0), b2, voffB);
            PG8_BAR; PG8_WAIT_L(0); PG8_MMA(0, 1, At, B1); PG8_BAR;
            PG8_LDA(At, 0, 1); PG8_STAGE(PG8_SA(0, 0), a2, voffA);
            PG8_BAR; PG8_WAIT_L(0); PG8_MMA(1, 0, At, B0); PG8_BAR; PG8_SCHED;
            PG8_STAGE(PG8_SB(0, 1), b2 + hstep, voffB);
            PG8_WAIT_V(6); PG8_BAR; PG8_MMA(1, 1, At, B1); PG8_BAR;
            PG8_LDB(B0, 1, 0); PG8_SCHED; PG8_LDA(At, 1, 0); PG8_STAGE(PG8_SA(0, 1), a2 + hstep, voffA);
            PG8_WAIT_L(8); PG8_BAR; PG8_WAIT_L(0); PG8_MMA(0, 0, At, B0); PG8_BAR; PG8_SCHED;
            PG8_LDB(B1, 1, 1); PG8_STAGE(PG8_SB(1, 0), b3, voffB);
            PG8_BAR; PG8_WAIT_L(0); PG8_MMA(0, 1, At, B1); PG8_BAR;
            PG8_LDA(At, 1, 1); PG8_STAGE(PG8_SA(1, 0), a3, voffA);
            PG8_BAR; PG8_WAIT_L(0); PG8_MMA(1, 0, At, B0); PG8_BAR; PG8_SCHED;
            PG8_STAGE(PG8_SB(1, 1), b3 + hstep, voffB);
            PG8_WAIT_V(6); PG8_BAR; PG8_MMA(1, 1, At, B1); PG8_BAR;
            }
        }
        if constexpr (ALIGN_EPI) { if (wr == 0) PG8_BAR; }
        if constexpr (F8) asm volatile("s_nop 15\n\ts_nop 15" ::: "memory");
        if constexpr (SKIPW) { if (has_next) PG8_WAIT_V(0); }
        if constexpr (!Epi::AFTER_DRAIN) { const int le_ = hw_lane(); E(acc, cur, wr, wc, le_ & 15, le_ >> 4); S.done(cur); }
        if (!has_next) break;
        if constexpr (Epi::HAS_INIT) { const int li_ = hw_lane(); E.init(acc, nxt, wr, wc, li_ & 15, li_ >> 4); } else {
#pragma unroll
        for (int a = 0; a < 2; ++a)
#pragma unroll
            for (int b = 0; b < 2; ++b)
#pragma unroll
                for (int m = 0; m < 4; ++m)
#pragma unroll
                    for (int n = 0; n < 2; ++n) acc[a][b][m][n] = (f32x4){0.f, 0.f, 0.f, 0.f};
        }
        cur = nxt; cA = nA; cB = nB; ++ui;
        if constexpr (ALIGN_EPI) { if (wr == 1) PG8_BAR; }
    }
    PG8_WAIT_V(0);
    if constexpr (!ALIGN_EPI) { if (wr == 0) PG8_BAR; }
    PG8_BAR;
    if constexpr (Epi::AFTER_DRAIN) { E.fused(acc, cur, wr, wc, fr, fq, lds, wid, lane); S.done(cur); }
#undef PG8_SA
#undef PG8_SB
#undef PG8_STAGE
#undef PG8_LDA
#undef PG8_LD1
#undef PG8_LDB
#undef PG8_MMA
#undef PG8_WAIT_V
#undef PG8_WAIT_L
#undef PG8_BAR
#undef PG8_SCHED
}
}
namespace att {
typedef unsigned short bf16;
typedef short bf16x8 __attribute__((ext_vector_type(8)));
typedef short s16x4 __attribute__((ext_vector_type(4)));
typedef float f32x16 __attribute__((ext_vector_type(16)));
typedef float f32x4 __attribute__((ext_vector_type(4)));
typedef unsigned u32x4 __attribute__((ext_vector_type(4)));
constexpr int NW = 8, QBLK = 32, KVBLK = 64, QB = NW * QBLK;
constexpr int SHM_V = KVBLK * 128 * 2;
constexpr float THR = 8.f;
struct CfgA { static constexpr bool EXT = false, SK = true, LSEOUT = true; static constexpr float SCALE = 0.08838834764831845f; };
struct CfgB { static constexpr bool EXT = true, SK = false, LSEOUT = false; static constexpr float SCALE = 0.07216878364870322f; };
template <class C> struct Geo { static constexpr int KROW = C::EXT ? 384 : 256, SHM_K = KVBLK * KROW;
    static constexpr int OFF_K = 2 * SHM_V, OFF_WS = OFF_K + 2 * SHM_K, OFF_QR = OFF_WS + NW * 64 * 4, LDS_BYTES = OFF_QR + (C::EXT ? NW * 4096 : 0); };
#define SBAR() __builtin_amdgcn_sched_barrier(0)
__device__ __forceinline__ int v_st(int k, int c) { const int kk = (k & ~0xC) | ((k & 4) << 1) | ((k & 8) >> 1); return ((kk >> 3) * 4 + (c >> 5)) * 512 + ((kk & 7) * 32 + (c & 31)) * 2; }
__device__ __forceinline__ int v_rd_base(int lane) { return ((lane & 3) << 3) | (((lane >> 2) & 3) << 6) | (((lane >> 4) & 1) << 5) | (((lane >> 5) & 1) << 8); }
constexpr int v_rd_off(int d0, int ks, int half) { return d0 * 512 + ks * 4096 + half * 2048; }
__device__ __forceinline__ int crow(int r, int hi) { return (r & 3) + 8 * (r >> 2) + 4 * hi; }
__device__ __forceinline__ unsigned cvtpk(float lo, float hi) { unsigned r; asm volatile("v_cvt_pk_bf16_f32 %0, %1, %2" : "=v"(r) : "v"(lo), "v"(hi)); return r; }
__device__ __forceinline__ bf16x8 load8(const bf16* p) { return *reinterpret_cast<const bf16x8*>(p); }
__device__ __forceinline__ void mask_tile(f32x16& p0, f32x16& p1, int dq, unsigned W) {
    const float NEG = -__builtin_inff();
#pragma unroll
    for (int r = 0; r < 16; ++r) {
        const int c = (r & 3) + 8 * (r >> 2);
        if ((unsigned)(dq - c) >= W) p0[r] = NEG;
        if ((unsigned)(dq - c - 32) >= W) p1[r] = NEG;
    }
}
template <class C>
__device__ __forceinline__ void partialSM(f32x16& p0, f32x16& p1, float& m_reg, float& mn, float& alpha) {
    constexpr float SCALE = C::SCALE;
    float pmax = p0[0];
#pragma unroll
    for (int r = 1; r < 16; ++r) pmax = fmaxf(pmax, p0[r]);
#pragma unroll
    for (int r = 0; r < 16; ++r) pmax = fmaxf(pmax, p1[r]);
    { auto rr = __builtin_amdgcn_permlane32_swap(__float_as_uint(pmax), __float_as_uint(pmax), false, false);
      pmax = fmaxf(__uint_as_float(rr[0]), __uint_as_float(rr[1])); }
    constexpr float C2 = 1.4426950408889634f * SCALE;
    if (__builtin_expect(__all((pmax - m_reg) * SCALE <= THR), 1)) { mn = m_reg; alpha = 1.f; }
    else { mn = fmaxf(m_reg, pmax); alpha = __builtin_amdgcn_exp2f((m_reg - mn) * C2); m_reg = mn; }
    const float mnL = -mn * C2;
#pragma unroll
    for (int r = 0; r < 16; ++r) p0[r] = fmaf(p0[r], C2, mnL);
#pragma unroll
    for (int r = 0; r < 16; ++r) p1[r] = fmaf(p1[r], C2, mnL);
#pragma unroll
    for (int r = 0; r < 16; ++r) p0[r] = __builtin_amdgcn_exp2f(p0[r]);
}
__device__ __forceinline__ void finishSM(f32x16& p0, f32x16& p1, float alpha, float& l_reg, bf16x8& pa0, bf16x8& pa1, bf16x8& pa2, bf16x8& pa3) {
#pragma unroll
    for (int r = 0; r < 16; ++r) p1[r] = __builtin_amdgcn_exp2f(p1[r]);
    float ps = 0;
#pragma unroll
    for (int r = 0; r < 16; ++r) ps += p0[r];
#pragma unroll
    for (int r = 0; r < 16; ++r) ps += p1[r];
    { auto rr = __builtin_amdgcn_permlane32_swap(__float_as_uint(ps), __float_as_uint(ps), false, false);
      ps = __uint_as_float(rr[0]) + __uint_as_float(rr[1]); }
    l_reg = l_reg * alpha + ps;
#define PK4(P, B_, OUT) do { unsigned a0 = cvtpk(P[B_+0], P[B_+1]), a1 = cvtpk(P[B_+2], P[B_+3]);                          \
        unsigned b0 = cvtpk(P[B_+4], P[B_+5]), b1 = cvtpk(P[B_+6], P[B_+7]);                                             \
        auto r0 = __builtin_amdgcn_permlane32_swap(a0, b0, false, false); auto r1 = __builtin_amdgcn_permlane32_swap(a1, b1, false, false); \
        u32x4 w = {r0[0], r1[0], r0[1], r1[1]}; OUT = *reinterpret_cast<bf16x8*>(&w); } while (0)
    PK4(p0, 0, pa0); PK4(p0, 8, pa1); PK4(p1, 0, pa2); PK4(p1, 8, pa3);
#undef PK4
}
#define KSWZ(row, colB) ((row) * KROW + ((colB) ^ (((row) & 7) << 4)))
template <class C, int KB>
__device__ __forceinline__ void qkt(f32x16& p0, f32x16& p1, const char* K_lds, const char* QR_w, int lane, int r32, int hi, const bf16x8* qr, bool act) {
    constexpr int KROW = Geo<C>::KROW, SHM_K = Geo<C>::SHM_K;
    if (C::SK && !act) { const float NEG = -__builtin_inff();
#pragma unroll
        for (int r = 0; r < 16; ++r) { p0[r] = NEG; p1[r] = NEG; } return; }
    p0 = f32x16{}; p1 = f32x16{};
    const char* kb[4];
#pragma unroll
    for (int dd = 0; dd < 4; ++dd) kb[dd] = K_lds + KB * SHM_K + KSWZ(r32, (dd * 16 + hi * 8) * 2);
#pragma unroll
    for (int d0 = 0; d0 < 8; ++d0) { const char* a = kb[d0 & 3] + (d0 >> 2) * 128;
        bf16x8 b0 = *reinterpret_cast<const bf16x8*>(a);
        bf16x8 b1 = *reinterpret_cast<const bf16x8*>(a + 32 * KROW);
        p0 = __builtin_amdgcn_mfma_f32_32x32x16_bf16(b0, qr[d0], p0, 0, 0, 0);
        p1 = __builtin_amdgcn_mfma_f32_32x32x16_bf16(b1, qr[d0], p1, 0, 0, 0); }
    if constexpr (C::EXT) {
#pragma unroll
        for (int d0 = 0; d0 < 4; ++d0) { const char* a = kb[d0] + 256;
            bf16x8 b0 = *reinterpret_cast<const bf16x8*>(a);
            bf16x8 b1 = *reinterpret_cast<const bf16x8*>(a + 32 * KROW);
            bf16x8 qf = *reinterpret_cast<const bf16x8*>(QR_w + (d0 * 64 + lane) * 16);
            p0 = __builtin_amdgcn_mfma_f32_32x32x16_bf16(b0, qf, p0, 0, 0, 0);
            p1 = __builtin_amdgcn_mfma_f32_32x32x16_bf16(b1, qf, p1, 0, 0, 0); }
    }
}
template <class C, int VB>
__device__ __forceinline__ void pv_tile(f32x16* o, int vb0, bf16x8 pa0, bf16x8 pa1, bf16x8 pa2, bf16x8 pa3, bool act) {
    if (C::SK && !act) return;
#define TRRD(dst, off) asm volatile("ds_read_b64_tr_b16 %0, %1 offset:%2" : "=&v"(dst) : "v"(vb0), "i"(off) : "memory")
#define PV_D0(d0) do { s16x4 l0, l1, l2, l3, h0, h1, h2, h3; constexpr int b_ = VB * SHM_V + v_rd_off(d0, 0, 0); \
        TRRD(l0, b_); TRRD(h0, b_ + 2048); TRRD(l1, b_ + 4096); TRRD(h1, b_ + 6144); TRRD(l2, b_ + 8192); TRRD(h2, b_ + 10240); TRRD(l3, b_ + 12288); TRRD(h3, b_ + 14336); \
        asm volatile("s_waitcnt lgkmcnt(0)" ::: "memory"); SBAR();   \
        o[d0] = __builtin_amdgcn_mfma_f32_32x32x16_bf16(pa0, (bf16x8){l0[0], l0[1], l0[2], l0[3], h0[0], h0[1], h0[2], h0[3]}, o[d0], 0, 0, 0);   \
        o[d0] = __builtin_amdgcn_mfma_f32_32x32x16_bf16(pa1, (bf16x8){l1[0], l1[1], l1[2], l1[3], h1[0], h1[1], h1[2], h1[3]}, o[d0], 0, 0, 0);   \
        o[d0] = __builtin_amdgcn_mfma_f32_32x32x16_bf16(pa2, (bf16x8){l2[0], l2[1], l2[2], l2[3], h2[0], h2[1], h2[2], h2[3]}, o[d0], 0, 0, 0);   \
        o[d0] = __builtin_amdgcn_mfma_f32_32x32x16_bf16(pa3, (bf16x8){l3[0], l3[1], l3[2], l3[3], h3[0], h3[1], h3[2], h3[3]}, o[d0], 0, 0, 0); } while (0)
    PV_D0(0); PV_D0(1); PV_D0(2); PV_D0(3);
#undef PV_D0
#undef TRRD
}
struct Tens { bf16* QN; bf16* QR; bf16* KN; bf16* KR; bf16* VB; bf16* OC; };
struct Blk { bf16* base; float* lse; int P0, ld, ldl, row0, hd; };
template <class C> __device__ __forceinline__ const bf16* q_row0(const Blk& b, const Tens& T) { if constexpr (C::EXT) return T.QN + (size_t)(b.row0 + b.P0) * 2048 + b.hd * 128; else return b.base + (size_t)b.P0 * b.ld; }
template <class C> __device__ __forceinline__ bf16* o_row0(const Blk& b, const Tens& T) { if constexpr (C::EXT) return T.OC + (size_t)(b.row0 + b.P0) * 2048 + b.hd * 128; else return b.base + (size_t)b.P0 * b.ld; }
template <class C> __device__ __forceinline__ const bf16* k_row0(const Blk& b, const Tens& T) { if constexpr (C::EXT) return T.KN + (size_t)b.row0 * 2048 + b.hd * 128; else return b.base + 2048; }
template <class C> __device__ __forceinline__ const bf16* v_row0(const Blk& b, const Tens& T) { if constexpr (C::EXT) return T.VB + (size_t)b.row0 * 2048 + b.hd * 128; else return b.base + 4096; }
template <class C> __device__ __forceinline__ int ld_of(const Blk& b) { if constexpr (C::EXT) return 2048; else return b.ld; }
__device__ __forceinline__ int swa_jlo(int P0, int W) { const int lowk = P0 - W + 1; return lowk > 0 ? lowk / KVBLK : 0; }
#define VMW() asm volatile("s_waitcnt vmcnt(0)" ::: "memory")
template <class C>
__device__ __forceinline__ void attn_block(const Blk& cur, const Tens& T, int skv, int W, char* lds, const int wave_in) {
    constexpr int KROW = Geo<C>::KROW, SHM_K = Geo<C>::SHM_K; constexpr bool SK = C::SK; constexpr float SCALE = C::SCALE;
    int tid_ = wave_in * 64 + hw_lane(); asm volatile("" : "+v"(tid_));
    const int tid = tid_, wid = __builtin_amdgcn_readfirstlane(tid >> 6), lane = tid & 63, r32 = lane & 31, hi = lane >> 5;
    const int j_lo = swa_jlo(cur.P0, W);
    int j_hi = (cur.P0 + QB - 1) / KVBLK + 1; if (j_hi > skv / KVBLK) j_hi = skv / KVBLK;
    const int NT = j_hi - j_lo;
    const int qlo = cur.P0 + wid * QBLK, qm = qlo + r32 - 4 * hi;
    char* V_lds = lds; char* K_lds = lds + Geo<C>::OFF_K;
    float* ws = (float*)(lds + Geo<C>::OFF_WS) + wid * 64; float* li_l = ws, * al_l = ws + 32;
    char* QR_w = lds + Geo<C>::OFF_QR + wid * 4096;
    const int sr = tid >> 4, sc = (tid & 15) * 8, vst0 = v_st(sr, sc), vst1 = v_st(32 + sr, sc), kws = KSWZ(sr, sc * 2);
    const int rr8 = tid >> 3, rc8 = (tid & 7) * 8, kwr = KSWZ(rr8, 256 + rc8 * 2);
    (void)kwr; (void)rr8; (void)rc8; (void)QR_w;
    const int vb0 = (int)(uintptr_t)V_lds + v_rd_base(lane);
    const bf16* kp = k_row0<C>(cur, T); const bf16* vp = v_row0<C>(cur, T); const int ld = ld_of<C>(cur);
    bf16x8 s0_v0, s0_v1, s0_k0, s0_k1, s0_kr, s1_v0, s1_v1, s1_k0, s1_k1, s1_kr;
    constexpr int NLD = C::EXT ? 5 : 4;
#define KBASE(t) ((j_lo + (t)) * KVBLK)
#define ACT(t) (KBASE(t) <= qlo + QBLK - 1 && KBASE(t) + KVBLK - 1 >= qlo - W + 1)
#define SLOAD(S_, k0) do { S_##_v0 = load8(vp + (size_t)((k0) + sr) * ld + sc); S_##_v1 = load8(vp + (size_t)((k0) + 32 + sr) * ld + sc); \
                       S_##_k0 = load8(kp + (size_t)((k0) + sr) * ld + sc); S_##_k1 = load8(kp + (size_t)((k0) + 32 + sr) * ld + sc); \
                       if constexpr (C::EXT) S_##_kr = load8(T.KR + (size_t)(cur.row0 + (k0) + rr8) * 64 + rc8); } while (0)
#define SWRITE(S_, bf) do { *(bf16x8*)(V_lds + (bf) * SHM_V + vst0) = S_##_v0; *(bf16x8*)(V_lds + (bf) * SHM_V + vst1) = S_##_v1; \
                        *(bf16x8*)(K_lds + (bf) * SHM_K + kws) = S_##_k0; *(bf16x8*)(K_lds + (bf) * SHM_K + kws + 32 * KROW) = S_##_k1; \
                        if constexpr (C::EXT) *(bf16x8*)(K_lds + (bf) * SHM_K + kwr) = S_##_kr; } while (0)
#define VMWN(n) asm volatile("s_waitcnt vmcnt(%0)" :: "i"(n) : "memory")
    bf16x8 qr[8];
    { const bf16* qp = q_row0<C>(cur, T) + (size_t)(wid * QBLK + r32) * ld + hi * 8;
#pragma unroll
      for (int d0 = 0; d0 < 8; ++d0) qr[d0] = load8(qp + d0 * 16); }
    if constexpr (C::EXT) {
#pragma unroll
        for (int d0 = 0; d0 < 4; ++d0) { const bf16x8 t = load8(T.QR + (size_t)(cur.row0 + cur.P0 + wid * QBLK + r32) * 1024 + cur.hd * 64 + d0 * 16 + hi * 8); *(bf16x8*)(QR_w + (d0 * 64 + lane) * 16) = t; }
    }
    SLOAD(s0, KBASE(0)); if (NT > 1) { SLOAD(s1, KBASE(1)); VMWN(NLD); } else { VMW(); } SWRITE(s0, 0);
    __syncthreads();
    float m_reg = -1e30f, l_reg = 0; f32x16 o[4] = {};
    f32x16 p0, p1; float mn, al; bf16x8 pa0, pa1, pa2, pa3;
#define STEP(t, BUF, SC_, SN_, FULL_) do {         \
        if (FULL_ || (t) + 2 < NT) { SLOAD(SC_, KBASE((t) + 2)); }                                                            \
        SBAR(); qkt<C, BUF>(p0, p1, K_lds, QR_w, lane, r32, hi, qr, ACT(t));                                                  \
        { const int kb_ = KBASE(t); if ((!SK || ACT(t)) && (kb_ + KVBLK - 1 > qlo || kb_ <= qlo + QBLK - 1 - W)) mask_tile(p0, p1, qm - kb_, (unsigned)W); } \
        partialSM<C>(p0, p1, m_reg, mn, al);                                                                                  \
        if (__any(al < 1.f)) { if (hi == 0) al_l[r32] = al; asm volatile("s_waitcnt lgkmcnt(0)" ::: "memory");              \
            for (int d_ = 0; d_ < 4; ++d_) for (int r = 0; r < 16; ++r) o[d_][r] *= al_l[crow(r, hi)]; }                      \
        finishSM(p0, p1, al, l_reg, pa0, pa1, pa2, pa3); SBAR();                                                              \
        pv_tile<C, BUF>(o, vb0, pa0, pa1, pa2, pa3, ACT(t));                                                                  \
        if (FULL_) { VMWN(NLD); SWRITE(SN_, (BUF) ^ 1); }                                                                     \
        else if ((t) + 1 < NT) { if ((t) + 2 < NT) { VMWN(NLD); } else { VMW(); } SWRITE(SN_, (BUF) ^ 1); }                   \
        __syncthreads(); } while (0)
    int t = 0;
    for (; t + 3 < NT; t += 2) { STEP(t, 0, s0, s1, true); STEP(t + 1, 1, s1, s0, true); }
    for (; t < NT; t += 2) { STEP(t, 0, s0, s1, false); if (t + 1 < NT) STEP(t + 1, 1, s1, s0, false); }
    if (hi == 0) li_l[r32] = l_reg; asm volatile("s_waitcnt lgkmcnt(0)" ::: "memory");
    if constexpr (C::LSEOUT) { if (hi == 0) cur.lse[(size_t)(cur.P0 + wid * QBLK + r32) * cur.ldl] = m_reg * SCALE + __logf(l_reg); }
    float rli[16];
#pragma unroll
    for (int r = 0; r < 16; ++r) rli[r] = __builtin_amdgcn_rcpf(li_l[crow(r, hi)]);
    char* Ost = lds + wid * 8192;
#pragma unroll
    for (int r = 0; r < 16; ++r) { const int orow = crow(r, hi);
#pragma unroll
        for (int d0 = 0; d0 < 4; ++d0) { const float v = o[d0][r] * rli[r];
            const float vn = __shfl_xor(v, 1);
            if ((r32 & 1) == 0) *(unsigned*)(Ost + orow * 256 + (d0 * 32 + r32) * 2) = cvtpk(v, vn); } }
    asm volatile("s_waitcnt lgkmcnt(0)" ::: "memory");
    bf16* Ow = o_row0<C>(cur, T) + (size_t)(wid * QBLK) * ld;
#pragma unroll
    for (int j = 0; j < 8; ++j) { const int ch = j * 64 + lane, row = ch >> 4, cc = ch & 15;
        const u32x4 val = *(const u32x4*)(Ost + row * 256 + cc * 16);
        *(u32x4*)(Ow + (size_t)row * ld + cc * 8) = val; }
    __syncthreads();
#undef KBASE
#undef ACT
#undef SLOAD
#undef SWRITE
#undef STEP
#undef VMWN
}
#undef VMW
#undef KSWZ
#undef SBAR
}
#define GAS __attribute__((address_space(1)))
#define LAS __attribute__((address_space(3)))
typedef unsigned short bf16;
typedef unsigned v4u __attribute__((ext_vector_type(4)));
typedef float f32x4 __attribute__((ext_vector_type(4)));
typedef short bf16x8 __attribute__((ext_vector_type(8)));
typedef GAS unsigned gu32;
typedef GAS unsigned long long gu64;
#define RLX_AGENT __ATOMIC_RELAXED, __HIP_MEMORY_SCOPE_AGENT
#define LDS_WAIT() asm volatile("s_waitcnt lgkmcnt(0)" ::: "memory")
#define VM_WAIT() asm volatile("s_waitcnt vmcnt(0)" ::: "memory")
__device__ __forceinline__ unsigned long long rt() { return __builtin_amdgcn_s_memrealtime(); }
__device__ __forceinline__ unsigned f2bf(float f) { unsigned u = __builtin_bit_cast(unsigned, f); return (u + 0x7fffu + ((u >> 16) & 1u)) >> 16; }
__device__ __forceinline__ unsigned pk2(float lo, float hi) { return f2bf(lo) | (f2bf(hi) << 16); }

#define XB_TMO      128
#define XB_XCNT(j)  (256  + 64 * (j))
#define XB_XSUB(j)  (1280 + 64 * (j))
#define XB_XGEN(j)  (2304 + 64 * (j))
#define XB_TOP      3328
#define XB_TOPGEN   3392
#define XCD_BAR_WORDS 3456
#define XB_SPIN_CAP (1u << 18)

__device__ __forceinline__ unsigned xb_ld(unsigned* p)              { return __hip_atomic_load(p, __ATOMIC_RELAXED, __HIP_MEMORY_SCOPE_AGENT); }
__device__ __forceinline__ unsigned xb_add(unsigned* p, unsigned v) { return __hip_atomic_fetch_add(p, v, __ATOMIC_RELAXED, __HIP_MEMORY_SCOPE_AGENT); }
__device__ __forceinline__ unsigned xb_xcc_id() { return (unsigned)__builtin_amdgcn_s_getreg((3 << 11) | 20) & 0xFu; }
#define XB_SPIN(cond, bar) do { unsigned _sp = 0; while (cond) { __builtin_amdgcn_s_sleep(1); \
    if ((++_sp & 255u) == 0u) { if (xb_ld(&(bar)[XB_TMO])) break; if (_sp > XB_SPIN_CAP) { atomicAdd(&(bar)[XB_TMO], 1u); break; } } } } while (0)

struct XcdBarrier {
    unsigned* bar; unsigned x;
    volatile LAS unsigned* st;
};

__device__ __forceinline__ XcdBarrier xcd_barrier_post(unsigned* bar, volatile LAS unsigned* st, const bool thread0) {
    XcdBarrier b; b.bar = bar; b.x = xb_xcc_id(); b.st = st;
    if (thread0) (void)xb_add(&bar[XB_XCNT(b.x)], 1u);
    return b;
}
__device__ __forceinline__ void xcd_barrier_complete(unsigned* bar, unsigned x, unsigned& nloc, unsigned& nx) {
    const unsigned G = gridDim.x * gridDim.y * gridDim.z;
    unsigned sum, cnt, mine, sp = 0u;
    for (;;) {
        sum = 0u; cnt = 0u; mine = 0u;
#pragma unroll
        for (unsigned j = 0; j < 16; ++j) { const unsigned c = xb_ld(&bar[XB_XCNT(j)]); sum += c; cnt += (c > 0u) ? 1u : 0u; mine = (j == x) ? c : mine; }
        if (sum == G) break;
        __builtin_amdgcn_s_sleep(1);
        if ((++sp & 255u) == 0u) { if (xb_ld(&bar[XB_TMO])) break; if (sp > XB_SPIN_CAP) { atomicAdd(&bar[XB_TMO], 1u); break; } }
    }
    nloc = mine > 0u ? mine : 1u; nx = cnt > 0u ? cnt : 1u;
}

__device__ __forceinline__ void xcd_barrier(const XcdBarrier& b, const bool thread0) {
    asm volatile("s_waitcnt vmcnt(0)" ::: "memory");
    __syncthreads();
    if (thread0) {
        unsigned* bar = b.bar;
        __builtin_amdgcn_s_waitcnt(0);
        unsigned nloc = b.st[0], nx = b.st[1];
        if (nloc == 0u) { xcd_barrier_complete(bar, b.x, nloc, nx); b.st[0] = nloc; b.st[1] = nx; }
        const unsigned old = xb_add(&bar[XB_XSUB(b.x)], 1u);
        const unsigned gen = old / nloc;
        if (old + 1u == (gen + 1u) * nloc) {
            __builtin_amdgcn_fence(__ATOMIC_RELEASE, "agent");
            asm volatile("s_waitcnt vmcnt(0)" ::: "memory");
            const unsigned og = xb_add(&bar[XB_TOP], 1u);
            const unsigned tg = og / nx;
            if (og + 1u == (tg + 1u) * nx) xb_add(&bar[XB_TOPGEN], 1u);
            else XB_SPIN(xb_ld(&bar[XB_TOPGEN]) == tg, bar);
            __builtin_amdgcn_fence(__ATOMIC_ACQUIRE, "agent");
            xb_add(&bar[XB_XGEN(b.x)], 1u);
            asm volatile("s_waitcnt vmcnt(0)" ::: "memory");
        } else {
            XB_SPIN(xb_ld(&bar[XB_XGEN(b.x)]) == gen, bar);
            __builtin_amdgcn_fence(__ATOMIC_ACQUIRE, "agent");
            asm volatile("s_waitcnt vmcnt(0)" ::: "memory");
        }
    }
    __syncthreads();
}
#ifndef FP8_A1
#define FP8_A1 0
#endif
#ifndef CLK_PROBE
#define CLK_PROBE 0
#endif
#ifndef CLK_PROBE_STEP
#define CLK_PROBE_STEP 0
#endif
#ifndef DUP_OUT
#define DUP_OUT 1
#endif
#ifndef DUP_EW
#define DUP_EW 1
#endif
#ifndef DUP_SMALLG
#define DUP_SMALLG 1
#endif
#ifndef F2_WGM
#define F2_WGM 4
#endif
#ifndef DUP_CONV
#define DUP_CONV 1
#endif
#ifndef DUP_F1
#define DUP_F1 1
#endif
#ifndef DUP_F2
#define DUP_F2 1
#endif
#ifndef DUP_A1
#define DUP_A1 1
#endif
#ifndef DUP_A12
#define DUP_A12 1
#endif
#ifndef DUP_B4
#define DUP_B4 1
#endif
#ifndef EN_CONV
#define EN_CONV 1
#endif
#ifndef EN_F1
#define EN_F1 1
#endif
#ifndef EN_F2
#define EN_F2 1
#endif
#ifndef EN_A1
#define EN_A1 1
#endif
#ifndef EN_A2
#define EN_A2 1
#endif
#ifndef EN_A3
#define EN_A3 1
#endif
#ifndef EN_B1
#define EN_B1 1
#endif
#ifndef EN_B23
#define EN_B23 1
#endif
#ifndef EN_B4
#define EN_B4 1
#endif
#ifndef EN_C1
#define EN_C1 1
#endif
#ifndef EN_C2
#define EN_C2 1
#endif
#ifndef EN_OUT
#define EN_OUT 1
#endif
constexpr int NWAVES = 8;
#ifndef MK_PER_PHASE
#define MK_PER_PHASE 0
#endif
constexpr int BATCH = 2, SEQ = 8192, DM = 2048, DFF = 5632, M = BATCH * SEQ;
constexpr int NQKV = 18432;
constexpr int BQ = 1536, BKV = 512, BR = 64, BIN_PAD = 2304;
constexpr size_t MiB = 1u << 20;
constexpr size_t WS_CTL = 0, CTL_ZERO_BYTES = 1 * MiB;
constexpr size_t WS_COSA = 1 * MiB, WS_SINA = 2 * MiB, WS_COSB = 3 * MiB, WS_SINB = 5 * MiB;
constexpr size_t WS_SS = 7 * MiB, WS_SSQ = 9 * MiB, WS_SSKV = 11 * MiB, WS_LSE = 12 * MiB;
constexpr size_t WS_H32 = 16 * MiB, WS_HB = 144 * MiB, WS_OC = 208 * MiB, WS_BIG = 272 * MiB, WS_W = 848 * MiB, WS_WSTRIDE = 0, WS_END = 1076 * MiB;
constexpr size_t BG_CQ = 0, BG_CKV = 48 * MiB, BG_KR = 64 * MiB, BG_QN = 66 * MiB, BG_QR = 130 * MiB, BG_KN = 162 * MiB, BG_VB = 226 * MiB;
constexpr size_t BG_CU = 0, BG_BGATE = 64 * MiB;
constexpr size_t WE_AV8 = 69206016 + 25165824;
constexpr size_t WE_13A = 0, WE_2A = 23068672, WE_13B = 34603008, WE_2B = 57671680, WE_MIX0 = 69206016, WE_MIX1 = 106954752, WE_MIX2 = 111673344, WE_MIX3 = 113770496, WE_END = 117964800;
static_assert(WS_W + WE_END * 2 <= WS_END, "weights fit");
constexpr int CW_BAR = 4096;
constexpr int RING_OFF = 0, RING_BYTES = 131072;
constexpr int LDSCTL_OFF = RING_BYTES, MISC_OFF = LDSCTL_OFF + 320;
constexpr int LDS_BYTES = 147456;
static_assert(att::Geo<att::CfgB>::LDS_BYTES <= RING_BYTES && att::Geo<att::CfgA>::LDS_BYTES <= RING_BYTES, "attention LDS fits the ring");

struct Args { const float* in[44]; float* out; unsigned char* ws; float invA[16]; float invB[32]; int ph_lo, ph_hi, use_bar, pad; };

__device__ __forceinline__ int layer_base(int L) { return L == 0 ? 2 : (L == 1 ? 11 : (L == 2 ? 24 : 34)); }
__device__ __forceinline__ float wave_sum(float v) {
#pragma unroll
    for (int o = 1; o < 64; o <<= 1) v += __shfl_xor(v, o);
    return v;
}
enum { MAP_ID = 0, MAP_FFN = 1, MAP_AQKV = 2, MAP_BIN = 3, MAP_BUQ = 4, MAP_CIN = 5, MAP_AQK = 6, MAP_AV = 7 };
__device__ __forceinline__ int map_col(int kind, int n) {
    switch (kind) {
    case MAP_FFN:  { const int pn = n >> 8, bj = (n >> 7) & 1, j = n & 127; return bj * DFF + pn * 128 + j; }
    case MAP_AQKV: { const int d = n & 127, t = (n >> 11) % 3; if (t < 2 && d < 32) { const int fqq = d >> 3, r = d & 7; return (n - d) + (r < 4 ? 4 * fqq + r : 16 + 4 * fqq + (r - 4)); } return n; }
    case MAP_AQK:  { const int gq = n >> 12, rem = n & 4095; return map_col(MAP_AQKV, gq * 6144 + rem); }
    case MAP_AV:   { return (n >> 11) * 6144 + 4096 + (n & 2047); }
    case MAP_BIN:  { if (n < 2048) return n; const int c = n - 2048; if (c < 32) return 2048 + c; if (c >= 128 && c < 160) return 2048 + 32 + (c - 128); return -1; }
    case MAP_BUQ:  { if (n < 2048) { const int head = n >> 7, d = n & 127; return head * 192 + d; } const int tt = (n - 2048) >> 8, bj = (n >> 7) & 1, c = n & 127; return (tt * 4 + (c >> 5)) * 192 + 128 + (c & 31) + 32 * bj; }
    case MAP_CIN:  { if (n < 4096) { const int pn = n >> 8, bj = (n >> 7) & 1, j = n & 127; return 2048 + bj * 2048 + pn * 128 + j; } return n - 4096; }
    default: return n;
    }
}
__device__ __forceinline__ void conv_item(const float* W, int K, int Nsrc, bf16* WT, int Ndst, int kind, const float* gain, float f8, LAS float* scr, int item, int lane) {
    const int nblk = Ndst >> 5, kb = item / nblk, nb = item - kb * nblk, k0 = 64 * kb, n0 = 32 * nb;
    const int scol = map_col(kind, n0 + (lane & 31));
    const float* src = W + (size_t)(k0 + (lane >> 5)) * Nsrc + (scol < 0 ? 0 : scol);
#pragma unroll 8
    for (int i = 0; i < 32; ++i) { float v = __builtin_nontemporal_load(src + (size_t)(2 * i) * Nsrc);     if (scol < 0) v = 0.f; scr[(2 * i + (lane >> 5)) * 33 + (lane & 31)] = v; }
    LDS_WAIT(); asm volatile("" ::: "memory");
    const int c = lane & 7;
    f32x4 g0 = {1.f, 1.f, 1.f, 1.f}, g1 = {1.f, 1.f, 1.f, 1.f};
    if (gain) { g0 = *(const f32x4*)(gain + k0 + 8 * c); g1 = *(const f32x4*)(gain + k0 + 8 * c + 4); }
#pragma unroll
    for (int j = 0; j < 4; ++j) { const int n = (lane >> 3) + 8 * j; const LAS float* s = scr + (8 * c) * 33 + n;
        if (f8 > 0.f) { const f32x4 a = {s[0 * 33] * g0[0] * f8, s[1 * 33] * g0[1] * f8, s[2 * 33] * g0[2] * f8, s[3 * 33] * g0[3] * f8}, b = {s[4 * 33] * g1[0] * f8, s[5 * 33] * g1[1] * f8, s[6 * 33] * g1[2] * f8, s[7 * 33] * g1[3] * f8};
            *(pg8::u32x2*)((unsigned char*)WT + (size_t)(n0 + n) * K + k0 + 8 * c) = pg8::pack8f8(a, b); }
        else if (f8 < 0.f) { v4u o; o.x = pg8::pkh2(s[0 * 33] * g0[0], s[1 * 33] * g0[1]); o.y = pg8::pkh2(s[2 * 33] * g0[2], s[3 * 33] * g0[3]); o.z = pg8::pkh2(s[4 * 33] * g1[0], s[5 * 33] * g1[1]); o.w = pg8::pkh2(s[6 * 33] * g1[2], s[7 * 33] * g1[3]);
            *(v4u*)(WT + (size_t)(n0 + n) * K + k0 + 8 * c) = o; }
        else { v4u o; o.x = pk2(s[0 * 33] * g0[0], s[1 * 33] * g0[1]); o.y = pk2(s[2 * 33] * g0[2], s[3 * 33] * g0[3]); o.z = pk2(s[4 * 33] * g1[0], s[5 * 33] * g1[1]); o.w = pk2(s[6 * 33] * g1[2], s[7 * 33] * g1[3]);
        *(v4u*)(WT + (size_t)(n0 + n) * K + k0 + 8 * c) = o; } }
    LDS_WAIT(); asm volatile("" ::: "memory");
}
__device__ __forceinline__ int conv_job(const float* W, int K, int Nsrc, bf16* WT, int Ndst, int kind, const float* gain, float f8, LAS float* scr, int lane, int gw, int NGW, int base) {
    const int nitems = (K >> 6) * (Ndst >> 5);
    int first = (gw - base) % NGW; if (first < 0) first += NGW;
    for (int it = first; it < nitems; it += NGW) conv_item(W, K, Nsrc, WT, Ndst, kind, gain, f8, scr, it, lane);
    return base + nitems;
}
constexpr float HFMT = 0.f;
struct ConvJob { int src, K, Nsrc, Ndst, map, gain; unsigned dst; float f8; };
__device__ __forceinline__ ConvJob conv_job_desc(int li, int kind, int jb) {
    const int n2 = li + (kind == 0 ? 6 : (kind == 1 ? 10 : 7));
    ConvJob J;
    switch (jb) {
    case 0:  J = ConvJob{li + 1, DM, 2 * DFF, 2 * DFF, MAP_FFN, li, (unsigned)WE_13A, HFMT}; break;
    case 1:  J = ConvJob{li + 2, DFF, DM, DM, MAP_ID, -1, (unsigned)WE_2A, 0.f}; break;
    case 2:  J = ConvJob{n2 + 1, DM, 2 * DFF, 2 * DFF, MAP_FFN, n2, (unsigned)WE_13B, HFMT}; break;
    case 3:  J = ConvJob{n2 + 2, DFF, DM, DM, MAP_ID, -1, (unsigned)WE_2B, 0.f}; break;
    case 4:  if (kind == 0) J = FP8_A1 ? ConvJob{li + 4, DM, NQKV, 12288, MAP_AQK, li + 3, (unsigned)WE_MIX0, 0.f} : ConvJob{li + 4, DM, NQKV, NQKV, MAP_AQKV, li + 3, (unsigned)WE_MIX0, HFMT};
             else if (kind == 1) J = ConvJob{li + 4, DM, BQ + BKV + BR, BIN_PAD, MAP_BIN, li + 3, (unsigned)WE_MIX0, HFMT};
             else J = ConvJob{li + 4, DM, 3 * DM, 3 * DM, MAP_CIN, li + 3, (unsigned)WE_MIX0, HFMT};
             break;
    case 5:  if (kind == 1) J = ConvJob{li + 6, BQ, 3072, 3072, MAP_BUQ, li + 5, (unsigned)WE_MIX1, 0.f};
             else J = ConvJob{li + (kind == 0 ? 5 : 6), DM, DM, DM, MAP_ID, -1, (unsigned)WE_MIX1, 0.f};
             break;
    case 6:  if (kind == 0) J = ConvJob{li + 4, DM, NQKV, 6144, MAP_AV, li + 3, (unsigned)WE_AV8, 64.f};
             else J = ConvJob{li + 8, BKV, 4096, 4096, MAP_ID, li + 7, (unsigned)WE_MIX2, 0.f};
             break;
    default: J = ConvJob{li + 9, DM, DM, DM, MAP_ID, -1, (unsigned)WE_MIX3, 0.f}; break;
    }
    return J;
}
#define CONV_LAYER(L_) do { WSP_DECL; bf16* WBc_ = WB0 + (size_t)((L_) & 1) * (WS_WSTRIDE / 2); int lane_ = LANE(); asm volatile("" : "+v"(lane_)); const int li_ = layer_base(L_), kind_ = (L_) % 3, njobs_ = (kind_ == 1) ? 8 : ((kind_ == 0 && FP8_A1) ? 7 : 6); int base_ = 0; \
    for (int jb_ = 0; jb_ < njobs_; ++jb_) { const ConvJob J_ = conv_job_desc(li_, kind_, jb_); const float* gain_ = (J_.gain >= 0) ? args.in[J_.gain] : nullptr; \
        base_ = conv_job(args.in[J_.src], J_.K, J_.Nsrc, WBc_ + J_.dst, J_.Ndst, J_.map, gain_, J_.f8, scr, lane_, gw, NGW, base_); } } while (0)
__device__ __forceinline__ void sincos_d(double a, float& sn, float& cs) {
    const double k = __builtin_rint(a * 0.15915494309189533577);
    double r = __builtin_fma(-k, 6.28318530717958623200, a); r = __builtin_fma(-k, 2.4492935982947064e-16, r);
    const double r2 = r * r;
    double s = -1.0 / 51090942171709440000.0;
    s = s * r2 + 1.0 / 121645100408832000.0;
    s = s * r2 - 1.0 / 355687428096000.0;
    s = s * r2 + 1.0 / 1307674368000.0;
    s = s * r2 - 1.0 / 6227020800.0;
    s = s * r2 + 1.0 / 39916800.0;
    s = s * r2 - 1.0 / 362880.0;
    s = s * r2 + 1.0 / 5040.0;
    s = s * r2 - 1.0 / 120.0;
    s = s * r2 + 1.0 / 6.0;
    s = r - r * r2 * s;
    double c = 1.0 / 1124000727777607680000.0;
    c = c * r2 - 1.0 / 2432902008176640000.0;
    c = c * r2 + 1.0 / 6402373705728000.0;
    c = c * r2 - 1.0 / 20922789888000.0;
    c = c * r2 + 1.0 / 87178291200.0;
    c = c * r2 - 1.0 / 479001600.0;
    c = c * r2 + 1.0 / 3628800.0;
    c = c * r2 - 1.0 / 40320.0;
    c = c * r2 + 1.0 / 720.0;
    c = c * r2 - 1.0 / 24.0;
    c = c * r2 + 0.5;
    c = 1.0 - r2 * c;
    sn = (float)s; cs = (float)c;
}

__device__ __forceinline__ int lane_opaque() { int t = hw_lane(); asm volatile("" : "+v"(t)); return t; }
template <int NPART> __device__ __forceinline__ void fill_rstd(LAS float* tab, const float* SSp, int stride, float inv_n, int pm, int wave) {
    const int ln = hw_lane(), rw = pm * 256 + wave * 32 + (ln & 31); const float* p = SSp + (size_t)rw * stride + (ln >> 5) * (NPART / 2); float sm = 0.f;
#pragma unroll
    for (int k = 0; k < NPART / 8; ++k) { const f32x4 a = *(const f32x4*)(p + 4 * k); sm += (a[0] + a[1]) + (a[2] + a[3]); }
    sm += __shfl_xor(sm, 32);
    if (ln < 32) tab[wave * 32 + ln] = 1.0f / sqrtf(sm * inv_n + 1e-6f);
}
#define RSTD_TABLE(NPART_, SSP_, STRIDE_, INVN_) LAS float* rsl = (LAS float*)(lds + LDSCTL_OFF + 4096); { pg8::Unit u0_; u0_.pm = 0; u0_.pn = 0; (void)S.next(0, u0_); fill_rstd<NPART_>(rsl, SSP_, STRIDE_, INVN_, u0_.pm, wave); } __syncthreads()
__global__ void __launch_bounds__(NWAVES * 64, 2) mk_fwd(Args args) {
    extern __shared__ __attribute__((aligned(16))) unsigned char lds_raw[];
    LAS unsigned char* lds = (LAS unsigned char*)lds_raw;
    volatile LAS unsigned* MISC = (volatile LAS unsigned*)(lds + MISC_OFF);
    const int wave = __builtin_amdgcn_readfirstlane((int)(threadIdx.x >> 6));
#define tid (wave * 64 + hw_lane())
#define T0 (wave == 0 && hw_lane() == 0)
#define LANE() lane_opaque()
    const int G = gridDim.x; const int bx = blockIdx.x; const int vcu = (G % 8 == 0) ? (bx % 8) * (G / 8) + bx / 8 : bx;
    const int gw = vcu * NWAVES + wave, NGW = G * NWAVES;
#define WSP_DECL GAS unsigned char* wsp = (GAS unsigned char*)args.ws; asm volatile("" : "+s"(wsp))
#define cosA ((float*)(wsp + WS_COSA))
#define sinA ((float*)(wsp + WS_SINA))
#define cosB ((float*)(wsp + WS_COSB))
#define sinB ((float*)(wsp + WS_SINB))
#define SS ((float*)(wsp + WS_SS))
#define SSQ ((float*)(wsp + WS_SSQ))
#define SSKV ((float*)(wsp + WS_SSKV))
#define LSE ((float*)(wsp + WS_LSE))
#define HLO ((bf16*)(wsp + WS_H32))
#define HB ((bf16*)(wsp + WS_HB))
#define OC ((bf16*)(wsp + WS_OC))
#define HB8 ((unsigned char*)(wsp + 80 * MiB))
#define BIG ((unsigned char*)(wsp + WS_BIG))
#define WB0 ((bf16*)(wsp + WS_W))
#define WB WB0
#define HID ((bf16*)BIG)
#define QKV ((bf16*)BIG)
#define CQ ((bf16*)(BIG + BG_CQ))
#define CKV ((bf16*)(BIG + BG_CKV))
#define KR ((bf16*)(BIG + BG_KR))
#define QN ((bf16*)(BIG + BG_QN))
#define QRo ((bf16*)(BIG + BG_QR))
#define KN ((bf16*)(BIG + BG_KN))
#define VB ((bf16*)(BIG + BG_VB))
#define CU ((bf16*)(BIG + BG_CU))
#define BGt ((bf16*)(BIG + BG_BGATE))
    unsigned* ctl = (unsigned*)(args.ws + WS_CTL);
    for (int u = tid; u < (LDS_BYTES - LDSCTL_OFF) / 4; u += NWAVES * 64) ((LAS unsigned*)(lds + LDSCTL_OFF))[u] = 0u;
    __syncthreads();
    XcdBarrier bar; bar.bar = ctl + CW_BAR; bar.x = 0; bar.st = nullptr;
    if (args.use_bar) bar = xcd_barrier_post(ctl + CW_BAR, MISC + 8, T0);
    const int lo = args.ph_lo, hi = args.ph_hi;
    int ph = 0;
#define IN_PH() (lo <= ph && ph < hi)
#if CLK_PROBE == 2
#define SEAM() do { if (lo <= ph && ph + 1 < hi) { const unsigned long long tb0_ = __builtin_amdgcn_s_memrealtime(); xcd_barrier(bar, T0); if (tid == 0) MISC[20] += (unsigned)(__builtin_amdgcn_s_memrealtime() - tb0_); } ++ph; } while (0)
#else
#define SEAM() do { if (lo <= ph && ph + 1 < hi) xcd_barrier(bar, T0); ++ph; } while (0)
#endif
    LAS float* scr = (LAS float*)(lds + RING_OFF + wave * 16384);

    if (IN_PH()) { WSP_DECL;
        const float* x = args.in[0]; const int* pos = (const int*)args.in[1]; const int lane = LANE();
        for (int m = gw; m < M; m += NGW) {
            const f32x4* xr = (const f32x4*)(x + (size_t)m * DM) + lane; float s = 0.f;
            unsigned long long* o8 = (unsigned long long*)(HB + (size_t)m * DM) + lane; unsigned long long* l8 = (unsigned long long*)(HLO + (size_t)m * DM) + lane;
#pragma unroll
            for (int j = 0; j < 8; ++j) { const f32x4 v = xr[64 * j]; s += (v[0] * v[0] + v[1] * v[1]) + (v[2] * v[2] + v[3] * v[3]);
                const unsigned w0 = pk2(v[0], v[1]), w1 = pk2(v[2], v[3]);
                o8[64 * j] = (unsigned long long)w0 | ((unsigned long long)w1 << 32);
                if (RES_MODE == 0) l8[64 * j] = (unsigned long long)pk2(v[0] - __uint_as_float(w0 << 16), v[1] - __uint_as_float(w0 & 0xffff0000u)) | ((unsigned long long)pk2(v[2] - __uint_as_float(w1 << 16), v[3] - __uint_as_float(w1 & 0xffff0000u)) << 32);
                if (RES_MODE == 2) l8[64 * j] = (unsigned long long)pg8::pkh2(v[0], v[1]) | ((unsigned long long)pg8::pkh2(v[2], v[3]) << 32); }
            s = wave_sum(s);
            if (lane < 32) SS[(size_t)m * 32 + lane] = (lane == 0) ? s : 0.f;
        }
        for (int i = gw * 64 + lane; i < M * 48; i += NGW * 64) {
            const int m = i / 48, j = i - m * 48; const float p = (float)pos[m];
            if (j < 16) { const float ang = p * args.invA[j]; float sn, cs; sincos_d((double)ang, sn, cs); cosA[m * 16 + j] = cs; sinA[m * 16 + j] = sn; }
            else { const int jj = j - 16; const float ang = p * args.invB[jj]; float sn, cs; sincos_d((double)ang, sn, cs); cosB[m * 32 + jj] = cs; sinB[m * 32 + jj] = sn; }
        }
#if EN_CONV
        for (int rep_ = 0; rep_ < DUP_CONV; ++rep_) { CONV_LAYER(0); }
#endif
    }
    SEAM();

    for (int s = 0; s < 12; ++s) {
        const int L = s / 3, r = s - 3 * L, kind = L % 3;
        if (r == 0 && L > 0) {
#if EN_CONV
            if (IN_PH()) for (int rep_ = 0; rep_ < DUP_CONV; ++rep_) { CONV_LAYER(L); }
#endif
            SEAM(); }
        if (r != 1) {
#if CLK_PROBE
            if (s == CLK_PROBE_STEP && r != 1 && bx == 0 && tid == 0 && CLK_PROBE == 1) { MISC[16] = (unsigned)__builtin_amdgcn_s_memtime(); MISC[17] = (unsigned)(__builtin_amdgcn_s_memtime() >> 32); MISC[18] = (unsigned)__builtin_amdgcn_s_memrealtime(); }
#endif
#if EN_F1
            for (int rep_ = 0; rep_ < DUP_F1; ++rep_) if (IN_PH()) { WSP_DECL; const bf16* ga_ = HB; const bf16* gb_ = WB + (r == 0 ? WE_13A : WE_13B); asm volatile("" : "+s"(ga_), "+s"(gb_)); pg8::Gemm g{ga_, gb_, M, 2 * DFF, DM}; pg8::StaticOrder S; S.init(M, 2 * DFF, G, bx);
                RSTD_TABLE(32, SS, 32, 1.0f / 2048.0f);
                pg8::EpiSwiGLU E{HID, DFF, rsl};
                pg8::gemm_phase<pg8::EpiSwiGLU, pg8::StaticOrder, true, true>(lds + RING_OFF, g, S, E, wave); }
#endif
#if CLK_PROBE
            if (s == CLK_PROBE_STEP && r != 1 && bx == 0 && tid == 0 && CLK_PROBE == 1) { const unsigned long long c1 = __builtin_amdgcn_s_memtime(); const unsigned w1 = (unsigned)__builtin_amdgcn_s_memrealtime(); const unsigned long long c0 = ((unsigned long long)MISC[17] << 32) | MISC[16]; MISC[19] = (unsigned)((c1 - c0) * 100ull / (unsigned long long)(w1 - MISC[18])); }
#endif
            SEAM();
#if EN_F2
            if (IN_PH()) { WSP_DECL; const bf16* ga_ = HID; const bf16* gb_ = WB + (r == 0 ? WE_2A : WE_2B); asm volatile("" : "+s"(ga_), "+s"(gb_)); pg8::Gemm g{ga_, gb_, M, DM, DFF}; pg8::StaticOrder S; S.init(M, DM, G, bx, F2_WGM);
                pg8::EpiResid<FP8_A1 != 0, true> E{HB, HLO, SS, HB8};
                pg8::gemm_phase<pg8::EpiResid<FP8_A1 != 0, true>, pg8::StaticOrder, true, true>(lds + RING_OFF, g, S, E, wave); }
#endif
            SEAM();
        } else {
            if (kind == 0) {
                for (int rep12_ = 0; rep12_ < DUP_A12; ++rep12_) { if (rep12_ > 0) { ph -= 2; }
#if EN_A1
#if FP8_A1
                for (int rep_ = 0; rep_ < DUP_A1; ++rep_) if (IN_PH()) { WSP_DECL;
                    { const bf16* ga_ = HB; const bf16* gb_ = WB + WE_MIX0; asm volatile("" : "+s"(ga_), "+s"(gb_));
                      pg8::Gemm g{ga_, gb_, M, 12288, DM}; pg8::StaticOrder S; S.init(M, 12288, G, bx);
                      RSTD_TABLE(32, SS, 32, 1.0f / 2048.0f);
                      pg8::EpiQKVA<1> E{QKV, rsl, cosA, sinA, 1.0f};
                      pg8::gemm_phase<pg8::EpiQKVA<1>, pg8::StaticOrder, true, true>(lds + RING_OFF, g, S, E, wave); }
                    { const bf16* ga_ = (const bf16*)HB8; const bf16* gb_ = WB + WE_AV8; asm volatile("" : "+s"(ga_), "+s"(gb_));
                      pg8::Gemm g{ga_, gb_, M, 6144, DM / 2}; pg8::StaticOrder S; S.init(M, 6144, G, bx);
                      RSTD_TABLE(32, SS, 32, 1.0f / 2048.0f);
                      pg8::EpiQKVA<2> E{QKV, rsl, cosA, sinA, 1.0f / 64.0f};
                      pg8::gemm_phase<pg8::EpiQKVA<2>, pg8::StaticOrder, true, true, true>(lds + RING_OFF, g, S, E, wave); }
                }
#else
                for (int rep_ = 0; rep_ < DUP_A1; ++rep_) if (IN_PH()) { WSP_DECL; const bf16* ga_ = HB; const bf16* gb_ = WB + WE_MIX0; asm volatile("" : "+s"(ga_), "+s"(gb_));
                    pg8::Gemm g{ga_, gb_, M, NQKV, DM}; pg8::StaticOrder S; S.init(M, NQKV, G, bx);
                    RSTD_TABLE(32, SS, 32, 1.0f / 2048.0f);
                    pg8::EpiQKVA<0> E{QKV, rsl, cosA, sinA, 1.0f};
                    pg8::gemm_phase<pg8::EpiQKVA<0>, pg8::StaticOrder, true, true>(lds + RING_OFF, g, S, E, wave); }
#endif
#endif
                SEAM();
#if EN_A2
                if (IN_PH()) { WSP_DECL;
                    att::Blk cur; att::Tens TT{nullptr, nullptr, nullptr, nullptr, nullptr, nullptr};
                    const int nblk = (3072 - bx + G - 1) / G;
#define ABLK(dst, Lx) do { const int L_ = (Lx); const int j_ = ((L_ & 31) + 3 * (L_ >> 8)) & 31, hd_ = (L_ >> 5) & 15,     \
        bg_ = L_ >> 9, g_ = bg_ % 3, b_ = bg_ / 3; const int dil_ = (g_ == 0) ? 1 : (g_ == 1 ? 4 : 16), nqb_ = 32 / dil_; \
        const int c_ = j_ / nqb_, qb_ = j_ - c_ * nqb_; const size_t t0_ = (size_t)b_ * SEQ + c_; dst.base = QKV + t0_ * NQKV + g_ * 6144 + hd_ * 128; dst.ld = dil_ * NQKV; \
        dst.P0 = qb_ * 256; dst.ldl = dil_ * 16; dst.lse = LSE + (size_t)g_ * M * 16 + t0_ * 16 + hd_; dst.row0 = 0; dst.hd = 0; } while (0)
                    for (int i = 0; i < nblk; ++i) {
                        ABLK(cur, bx + i * G);
                        const int g_ = ((bx + i * G) >> 9) % 3; const int skv = (g_ == 0) ? 8192 : (g_ == 1 ? 2048 : 512);
                        att::attn_block<att::CfgA>(cur, TT, skv, 129, (char*)lds_raw + RING_OFF, wave);
                    }
#undef ABLK
                }
#endif
                SEAM();
                }
#if EN_A3
                for (int rep_ = 0; rep_ < DUP_EW; ++rep_) if (IN_PH()) { WSP_DECL; int lane_ = LANE(); asm volatile("" : "+v"(lane_));
                    for (int m = gw; m < M; m += NGW) {
#pragma unroll
                        for (int j = 0; j < 4; ++j) { const int col = (j * 64 + lane_) * 8, hd = col >> 7;
                            const float l0 = LSE[(size_t)m * 16 + hd], l1 = LSE[(size_t)(M + m) * 16 + hd], l2 = LSE[(size_t)(2 * M + m) * 16 + hd];
                            const float mx = fmaxf(l0, fmaxf(l1, l2)); const float e0 = __expf(l0 - mx), e1 = __expf(l1 - mx), e2 = __expf(l2 - mx); const float inv = 1.0f / (e0 + e1 + e2);
                            const v4u a = *(const v4u*)(QKV + (size_t)m * NQKV + col), b = *(const v4u*)(QKV + (size_t)m * NQKV + 6144 + col), c = *(const v4u*)(QKV + (size_t)m * NQKV + 12288 + col);
                            v4u o;
#pragma unroll
                            for (int k = 0; k < 4; ++k) { const float alo = __uint_as_float(a[k] << 16), ahi = __uint_as_float(a[k] & 0xffff0000u), blo = __uint_as_float(b[k] << 16), bhi = __uint_as_float(b[k] & 0xffff0000u),
                                    clo = __uint_as_float(c[k] << 16), chi = __uint_as_float(c[k] & 0xffff0000u);
                                o[k] = pk2((alo * e0 + blo * e1 + clo * e2) * inv, (ahi * e0 + bhi * e1 + chi * e2) * inv); }
                            *(v4u*)(OC + (size_t)m * DM + col) = o; }
                    }
                }
#endif
                SEAM();
            } else if (kind == 1) {
#if EN_B1
                for (int rep_ = 0; rep_ < DUP_SMALLG; ++rep_) if (IN_PH()) { WSP_DECL; const bf16* ga_ = HB; const bf16* gb_ = WB + WE_MIX0; asm volatile("" : "+s"(ga_), "+s"(gb_)); pg8::Gemm g{ga_, gb_, M, BIN_PAD, DM}; pg8::StaticOrder S; S.init(M, BIN_PAD, G, bx);
                    pg8::EpiBin E{CQ, CKV, KR, SSQ, SSKV, SS, cosB, sinB};
                    pg8::gemm_phase<pg8::EpiBin, pg8::StaticOrder, true, true>(lds + RING_OFF, g, S, E, wave); }
#endif
                SEAM();
#if EN_B23
                for (int rep_ = 0; rep_ < DUP_SMALLG; ++rep_) if (IN_PH()) { WSP_DECL;
                    { const bf16* ga_ = CQ; const bf16* gb_ = WB + WE_MIX1; asm volatile("" : "+s"(ga_), "+s"(gb_)); pg8::Gemm g{ga_, gb_, M, 3072, BQ}; pg8::StaticOrder S; S.init(M, 3072, G, bx);
                      RSTD_TABLE(24, SSQ, 32, 1.0f / 1536.0f);
                      pg8::EpiUQ E{QN, QRo, rsl, cosB, sinB};
                      pg8::gemm_phase<pg8::EpiUQ, pg8::StaticOrder, true, true>(lds + RING_OFF, g, S, E, wave); }
                    { const bf16* ga_ = CKV; const bf16* gb_ = WB + WE_MIX2; asm volatile("" : "+s"(ga_), "+s"(gb_)); pg8::Gemm g{ga_, gb_, M, 4096, BKV}; pg8::StaticOrder S; S.init(M, 4096, G, bx);
                      RSTD_TABLE(8, SSKV, 8, 1.0f / 512.0f);
                      pg8::EpiUKV E{KN, VB, rsl};
                      pg8::gemm_phase<pg8::EpiUKV, pg8::StaticOrder, true, true>(lds + RING_OFF, g, S, E, wave); }
                }
#endif
                SEAM();
#if EN_B4
                for (int rep_ = 0; rep_ < DUP_B4; ++rep_) if (IN_PH()) { WSP_DECL;
                    att::Blk cur; att::Tens TT{QN, QRo, KN, KR, VB, OC};
                    const int nitem = (512 - bx + G - 1) / G, nblk = 2 * nitem;
#define BBLK(dst, ix) do { const int it_ = bx + ((ix) >> 1) * G, ps_ = (ix) & 1; const int bh_ = it_ >> 4, x_ = it_ & 15, qb_ = ps_ ? 31 - x_ : x_; \
        dst.row0 = (bh_ >> 4) * SEQ; dst.hd = bh_ & 15; dst.P0 = qb_ * 256; dst.base = nullptr; dst.lse = nullptr; dst.ld = 2048; dst.ldl = 0; } while (0)
                    for (int i = 0; i < nblk; ++i) {
                        BBLK(cur, i);
                        att::attn_block<att::CfgB>(cur, TT, SEQ, 1 << 30, (char*)lds_raw + RING_OFF, wave);
                    }
#undef BBLK
                }
#endif
                SEAM();
            } else {
#if EN_C1
                for (int rep_ = 0; rep_ < DUP_SMALLG; ++rep_) if (IN_PH()) { WSP_DECL; const bf16* ga_ = HB; const bf16* gb_ = WB + WE_MIX0; asm volatile("" : "+s"(ga_), "+s"(gb_)); pg8::Gemm g{ga_, gb_, M, 3 * DM, DM}; pg8::StaticOrder S; S.init(M, 3 * DM, G, bx);
                    RSTD_TABLE(32, SS, 32, 1.0f / 2048.0f);
                    pg8::EpiCin E{CU, BGt, rsl};
                    pg8::gemm_phase<pg8::EpiCin, pg8::StaticOrder, true, true>(lds + RING_OFF, g, S, E, wave); }
#endif
                SEAM();
#if EN_C2
                for (int rep_ = 0; rep_ < DUP_EW; ++rep_) if (IN_PH()) { WSP_DECL; const float* cw = args.in[layer_base(L) + 5]; int lane_ = LANE(); asm volatile("" : "+v"(lane_));
                    for (int m = gw; m < M; m += NGW) { const int t = m & (SEQ - 1);
#pragma unroll
                        for (int j = 0; j < 4; ++j) { const int col = (j * 64 + lane_) * 8;
                            const v4u x2 = *(const v4u*)(CU + (size_t)m * DM + col); v4u x1 = {0u, 0u, 0u, 0u}, x0 = {0u, 0u, 0u, 0u};
                            if (t >= 1) x1 = *(const v4u*)(CU + (size_t)(m - 1) * DM + col);
                            if (t >= 2) x0 = *(const v4u*)(CU + (size_t)(m - 2) * DM + col);
                            const v4u bg = *(const v4u*)(BGt + (size_t)m * DM + col);
                            const f32x4 w0a = *(const f32x4*)(cw + col), w0b = *(const f32x4*)(cw + col + 4), w1a = *(const f32x4*)(cw + DM + col), w1b = *(const f32x4*)(cw + DM + col + 4),
                                        w2a = *(const f32x4*)(cw + 2 * DM + col), w2b = *(const f32x4*)(cw + 2 * DM + col + 4);
                            v4u o;
#pragma unroll
                            for (int k = 0; k < 4; ++k) { const float wl0 = (k < 2) ? w0a[2 * k] : w0b[2 * k - 4], wh0 = (k < 2) ? w0a[2 * k + 1] : w0b[2 * k - 3];
                                const float wl1 = (k < 2) ? w1a[2 * k] : w1b[2 * k - 4], wh1 = (k < 2) ? w1a[2 * k + 1] : w1b[2 * k - 3];
                                const float wl2 = (k < 2) ? w2a[2 * k] : w2b[2 * k - 4], wh2 = (k < 2) ? w2a[2 * k + 1] : w2b[2 * k - 3];
                                const float zl = wl0 * __uint_as_float(x0[k] << 16) + wl1 * __uint_as_float(x1[k] << 16) + wl2 * __uint_as_float(x2[k] << 16);
                                const float zh = wh0 * __uint_as_float(x0[k] & 0xffff0000u) + wh1 * __uint_as_float(x1[k] & 0xffff0000u) + wh2 * __uint_as_float(x2[k] & 0xffff0000u);
                                o[k] = pk2(zl * __uint_as_float(bg[k] << 16), zh * __uint_as_float(bg[k] & 0xffff0000u)); }
                            *(v4u*)(OC + (size_t)m * DM + col) = o; }
                    }
                }
#endif
                SEAM();
            }
#if EN_OUT
            if (IN_PH()) { WSP_DECL; const bf16* ga_ = OC; const bf16* gb_ = WB + ((kind == 1) ? WE_MIX3 : WE_MIX1); asm volatile("" : "+s"(ga_), "+s"(gb_)); pg8::Gemm g{ga_, gb_, M, DM, DM}; pg8::StaticOrder S; S.init(M, DM, G, bx, F2_WGM);
                pg8::EpiResid<false, false> E{HB, HLO, SS, nullptr};
                pg8::gemm_phase<pg8::EpiResid<false, false>, pg8::StaticOrder, true, true>(lds + RING_OFF, g, S, E, wave); }
#endif
            SEAM();
        }
    }
    if (IN_PH()) { WSP_DECL; const float* gn = args.in[43]; const int lane = LANE();
        for (int m = gw; m < M; m += NGW) {
            float s = (lane < 32) ? SS[(size_t)m * 32 + lane] : 0.f; s = wave_sum(s);
            const float rs = 1.0f / sqrtf(s * (1.0f / 2048.0f) + 1e-6f);
            const unsigned long long* hr = (const unsigned long long*)(HB + (size_t)m * DM) + lane; const unsigned long long* lr = (const unsigned long long*)(HLO + (size_t)m * DM) + lane;
            f32x4* orow = (f32x4*)(args.out + (size_t)m * DM) + lane; const f32x4* gr = (const f32x4*)gn + lane;
#pragma unroll
            for (int j = 0; j < 8; ++j) { const unsigned long long a = (RES_MODE == 2) ? lr[64 * j] : hr[64 * j], b = (RES_MODE == 0) ? lr[64 * j] : 0ull; const unsigned a0 = (unsigned)a, a1 = (unsigned)(a >> 32), b0 = (unsigned)b, b1 = (unsigned)(b >> 32);
                const f32x4 h = (RES_MODE == 2) ? (f32x4){pg8::h_lo(a0), pg8::h_hi(a0), pg8::h_lo(a1), pg8::h_hi(a1)} : (f32x4){__uint_as_float(a0 << 16) + __uint_as_float(b0 << 16), __uint_as_float(a0 & 0xffff0000u) + __uint_as_float(b0 & 0xffff0000u), __uint_as_float(a1 << 16) + __uint_as_float(b1 << 16), __uint_as_float(a1 & 0xffff0000u) + __uint_as_float(b1 & 0xffff0000u)};
                orow[64 * j] = h * rs * gr[64 * j]; }
        }
    }
#if CLK_PROBE == 2
    if (tid == 0) atomicAdd(ctl + 2048, MISC[20]);
    xcd_barrier(bar, T0);
    if (bx == 0 && tid == 0) MISC[19] = __hip_atomic_load(ctl + 2048, __ATOMIC_RELAXED, __HIP_MEMORY_SCOPE_AGENT) / (unsigned)G / 100u;
    __syncthreads();
#endif
#if CLK_PROBE
    if (bx == 0 && tid == 0) { const unsigned mhz = MISC[19]; const unsigned long long t0 = __builtin_amdgcn_s_memrealtime(); while (__builtin_amdgcn_s_memrealtime() - t0 < (unsigned long long)mhz * 100ull) __builtin_amdgcn_s_sleep(32); }
#endif
#undef IN_PH
#undef SEAM
}

constexpr int N_PHASES = 36;
extern "C" void kernel_launch(void* const* d_in, const int* in_sizes, int n_in, void* d_out, int out_size, void* d_ws, size_t ws_size, hipStream_t stream) {
    static int grid = 0;
    if (grid == 0) {
        if (n_in != 44 || in_sizes[0] != M * DM || out_size != M * DM || ws_size < WS_END) { fprintf(stderr, "kernel_launch: unexpected shapes (n_in %d, in0 %d, out %d, ws %zu); nothing launched\n", n_in, n_in > 0 ? in_sizes[0] : -1, out_size, ws_size); grid = -1; return; }
        int dev = 0, cus = 0, per_cu = 0;
        if (hipGetDevice(&dev) != hipSuccess || hipDeviceGetAttribute(&cus, hipDeviceAttributeMultiprocessorCount, dev) != hipSuccess) { grid = -1; return; }
        if (hipFuncSetAttribute((const void*)mk_fwd, hipFuncAttributeMaxDynamicSharedMemorySize, LDS_BYTES) != hipSuccess) { fprintf(stderr, "kernel_launch: hipFuncSetAttribute failed\n"); grid = -1; return; }
        if (hipOccupancyMaxActiveBlocksPerMultiprocessor(&per_cu, (const void*)mk_fwd, NWAVES * 64, LDS_BYTES) != hipSuccess || per_cu < 1) fprintf(stderr, "kernel_launch: occupancy query reports %d\n", per_cu);
        (void)hipGetLastError();
        grid = cus;
    }
    if (grid < 0) return;
    if (hipMemsetAsync((char*)d_ws + WS_CTL, 0, CTL_ZERO_BYTES, stream) != hipSuccess) return;
    Args a{};
    for (int i = 0; i < 44; ++i) a.in[i] = (const float*)d_in[i];
    a.out = (float*)d_out; a.ws = (unsigned char*)d_ws;
    for (int i = 0; i < 16; ++i) a.invA[i] = (float)pow(500000.0, -(double)i / 16.0);
    for (int i = 0; i < 32; ++i) a.invB[i] = (float)pow(500000.0, -(double)i / 32.0);
#if MK_PER_PHASE
    for (int p = 0; p < N_PHASES; ++p) { a.ph_lo = p; a.ph_hi = p + 1; a.use_bar = 0; a.pad = 0;
        hipLaunchKernelGGL(mk_fwd, dim3(grid), dim3(NWAVES * 64), LDS_BYTES, stream, a); }
#else
    a.ph_lo = 0; a.ph_hi = N_PHASES; a.use_bar = 1; a.pad = 0;
    hipLaunchKernelGGL(mk_fwd, dim3(grid), dim3(NWAVES * 64), LDS_BYTES, stream, a);
#endif
}
```
